# Optimizing an MI355X kernel written in HIP

```python
import math
import jax, jax.numpy as jnp
from jax import lax
import numpy as np

D_MODEL = 1024
BATCH = 32
SEQ = 2048
DEPTH = 2

N_META = 16
EPS = 1e-6
A_HEADS = 4
A_DK = 128
A_DV = 128
A_CONV = 4
A_CHUNK = 64
A_WK = A_HEADS * A_DK
A_WV = A_HEADS * A_DV
B_HEADS = 4
B_DK = 128
B_DV = 128
B_CHUNK = 16
B_WK = B_HEADS * B_DK
B_WV = B_HEADS * B_DV
PROJ_SPLITS = (A_WK, A_WK, A_WV, A_HEADS, A_HEADS, A_WV, B_WK, B_WK, B_WV, B_WV, D_MODEL, D_MODEL)
PROJ_WIDTH = sum(PROJ_SPLITS)

kernel_name = 'hybrid_gdn_hgrn2_gated_merge'


def _rmsnorm(x, w):
    xf = x.astype(jnp.float32)
    y = xf * lax.rsqrt(jnp.mean(xf * xf, axis=-1, keepdims=True) + EPS)
    return (y * w.astype(jnp.float32)).astype(x.dtype)


def _l2norm(x):
    xf = x.astype(jnp.float32)
    return xf * lax.rsqrt(jnp.sum(xf * xf, axis=-1, keepdims=True) + EPS)


def _causal_conv(x, w):
    k, c = w.shape
    return lax.conv_general_dilated(
        x, w[:, None, :].astype(x.dtype), window_strides=(1,), padding=[(k - 1, 0)],
        dimension_numbers=('NWC', 'WIO', 'NWC'), feature_group_count=c)


def _masked_exp(diff, mask):
    return jnp.where(mask, jnp.exp(jnp.where(mask, diff, 0.0)), 0.0)


def _chunked_scan(step, state0, inputs, chunk):
    meta = tuple(a[:, :N_META] for a in inputs)
    real = tuple(a[:, N_META:] for a in inputs)
    state, out_meta = step(state0, meta)
    b, s = real[0].shape[:2]
    n = s // chunk
    xs = tuple(jnp.moveaxis(a.reshape(b, n, chunk, *a.shape[2:]), 1, 0) for a in real)
    _, out_real = lax.scan(step, state, xs)
    out_real = jnp.moveaxis(out_real, 0, 1).reshape(b, s, *out_real.shape[3:])
    return jnp.concatenate([out_meta, out_real], axis=1)


def _gdn_step(S, inp):
    q, k, v, beta, g = inp
    q, k, v = (jnp.swapaxes(a, 1, 2) for a in (q, k, v))
    beta, g = jnp.swapaxes(beta, 1, 2), jnp.swapaxes(g, 1, 2)
    L = q.shape[2]
    causal = jnp.tril(jnp.ones((L, L), dtype=bool))
    strict = jnp.tril(jnp.ones((L, L), dtype=bool), k=-1)
    G = jnp.cumsum(g, axis=-1)
    decay = _masked_exp(G[..., :, None] - G[..., None, :], causal)
    kb = k * beta[..., None]
    l_mat = jnp.where(strict, jnp.einsum('bhik,bhjk->bhij', kb, k) * decay, 0.0)
    t_mat = l_mat + jnp.eye(L, dtype=l_mat.dtype)
    rhs = jnp.concatenate([v * beta[..., None], kb * jnp.exp(G)[..., None]], axis=-1)
    sol = lax.linalg.triangular_solve(t_mat, rhs, left_side=True, lower=True, unit_diagonal=True)
    dv = v.shape[-1]
    u, w = sol[..., :dv], sol[..., dv:]
    v_new = u - jnp.einsum('bhik,bhkv->bhiv', w, S)
    scores = jnp.einsum('bhik,bhjk->bhij', q, k) * decay
    o = (jnp.einsum('bhik,bhkv->bhiv', q * jnp.exp(G)[..., None], S)
         + jnp.einsum('bhij,bhjv->bhiv', scores, v_new))
    g_last = G[..., -1:]
    S = (S * jnp.exp(g_last)[..., None]
         + jnp.einsum('bhjk,bhjv->bhkv', k * jnp.exp(g_last - G)[..., None], v_new))
    return S, jnp.swapaxes(o, 1, 2)


def _hgrn2_step(S, inp):
    q, k, v, log_f = (jnp.swapaxes(a, 1, 2) for a in inp)
    L = q.shape[2]
    causal = jnp.tril(jnp.ones((L, L), dtype=bool))
    Bc = jnp.cumsum(log_f, axis=2)
    pair = _masked_exp(Bc[:, :, :, None, :] - Bc[:, :, None, :, :],
                       causal[:, :, None])
    scores = jnp.einsum('bhik,bhjk,bhijk->bhij', q, k, pair)
    o = (jnp.einsum('bhik,bhkv->bhiv', q * jnp.exp(Bc), S)
         + jnp.einsum('bhij,bhjv->bhiv', scores, v))
    b_last = Bc[:, :, -1:]
    S = (S * jnp.exp(b_last[:, :, 0])[..., None]
         + jnp.einsum('bhjk,bhjv->bhkv', k * jnp.exp(b_last - Bc), v))
    return S, jnp.swapaxes(o, 1, 2)


def _layer(h, norm_w, w_in, conv_w, a_log, dt_bias, gnorm_a, gnorm_b, lb,
           w_branch_a, w_branch_b, w_out):
    b, t, _ = h.shape
    f32 = jnp.float32
    xn = _rmsnorm(h, norm_w)
    proj = xn @ w_in.astype(h.dtype)
    offsets = np.cumsum(PROJ_SPLITS)[:-1].tolist()
    (a_q, a_k, a_v, a_beta, a_alpha, a_z,
     b_q, b_f, b_i, b_g, gate_a, gate_b) = jnp.split(proj, offsets, axis=-1)

    qkv = jax.nn.silu(_causal_conv(jnp.concatenate([a_q, a_k, a_v], axis=-1), conv_w))
    q, k, v = jnp.split(qkv, [A_WK, 2 * A_WK], axis=-1)
    q = _l2norm(q.reshape(b, t, A_HEADS, A_DK)) * (A_DK ** -0.5)
    k = _l2norm(k.reshape(b, t, A_HEADS, A_DK))
    v = v.reshape(b, t, A_HEADS, A_DV).astype(f32)
    beta = jax.nn.sigmoid(a_beta.astype(f32))
    g = -jnp.exp(a_log.astype(f32)) * jax.nn.softplus(a_alpha.astype(f32) + dt_bias.astype(f32))
    s0_a = jnp.zeros((b, A_HEADS, A_DK, A_DV), f32)
    o_a = _chunked_scan(_gdn_step, s0_a, (q, k, v, beta, g), A_CHUNK)
    y_a = _rmsnorm(o_a, gnorm_a) * jax.nn.silu(a_z.astype(f32).reshape(b, t, A_HEADS, A_DV))
    y_a = y_a.reshape(b, t, A_WV).astype(h.dtype)

    qb = (jax.nn.silu(b_q.astype(f32)) * (B_DK ** -0.5)).reshape(b, t, B_HEADS, B_DK)
    lbf = lb.astype(f32)
    pos = lbf > 0.0
    log_sig = jax.nn.log_sigmoid(b_f.astype(f32))
    log_f = jnp.where(pos,
                      jnp.logaddexp(jnp.log(jnp.where(pos, lbf, 1.0)), jnp.log1p(-lbf) + log_sig),
                      log_sig)
    kb_ = -jnp.expm1(log_f)
    log_f = log_f.reshape(b, t, B_HEADS, B_DK)
    kb_ = kb_.reshape(b, t, B_HEADS, B_DK)
    vb = b_i.astype(f32).reshape(b, t, B_HEADS, B_DV)
    s0_b = jnp.zeros((b, B_HEADS, B_DK, B_DV), f32)
    o_b = _chunked_scan(_hgrn2_step, s0_b, (qb, kb_, vb, log_f), B_CHUNK)
    y_b = _rmsnorm(o_b, gnorm_b) * jax.nn.silu(b_g.astype(f32).reshape(b, t, B_HEADS, B_DV))
    y_b = y_b.reshape(b, t, B_WV).astype(h.dtype)

    y_a = y_a @ w_branch_a.astype(h.dtype)
    y_b = y_b @ w_branch_b.astype(h.dtype)
    mixed = jax.nn.sigmoid(gate_a) * y_a + jax.nn.sigmoid(gate_b) * y_b
    return h + mixed @ w_out.astype(h.dtype)


def setup_inputs(seed: int = 0) -> dict:
    key = jax.random.key(seed)
    ks = jax.random.split(key, 15)
    nrm = jax.random.normal
    x = nrm(ks[0], (BATCH, SEQ, D_MODEL), jnp.float32)
    meta_tokens = nrm(ks[1], (N_META, D_MODEL), jnp.float32)
    norm_w = 1.0 + 0.02 * nrm(ks[2], (DEPTH, D_MODEL), jnp.float32)
    w_in = nrm(ks[3], (DEPTH, D_MODEL, PROJ_WIDTH), jnp.float32) * D_MODEL ** -0.5
    conv_w = nrm(ks[4], (DEPTH, A_CONV, 2 * A_WK + A_WV), jnp.float32) * A_CONV ** -0.5
    a_log = jnp.log(jax.random.uniform(ks[5], (DEPTH, A_HEADS), jnp.float32, 1.0, 16.0))
    dt = jnp.exp(jax.random.uniform(ks[6], (DEPTH, A_HEADS), jnp.float32,
                                    math.log(1e-3), math.log(1e-1)))
    dt_bias = dt + jnp.log(-jnp.expm1(-dt))
    gnorm_a = 1.0 + 0.02 * nrm(ks[7], (DEPTH, A_DV), jnp.float32)
    gnorm_b = 1.0 + 0.02 * nrm(ks[8], (DEPTH, B_DV), jnp.float32)
    hgrn_lower_bounds = 0.1 * nrm(ks[9], (DEPTH, B_WK), jnp.float32)
    w_branch_a = nrm(ks[10], (DEPTH, A_WV, D_MODEL), jnp.float32) * A_WV ** -0.5
    w_branch_b = nrm(ks[11], (DEPTH, B_WV, D_MODEL), jnp.float32) * B_WV ** -0.5
    w_out = nrm(ks[12], (DEPTH, D_MODEL, D_MODEL), jnp.float32) * D_MODEL ** -0.5
    final_norm_w = 1.0 + 0.02 * nrm(ks[13], (D_MODEL,), jnp.float32)
    return {'x': x, 'meta_tokens': meta_tokens, 'norm_w': norm_w, 'w_in': w_in,
            'conv_w': conv_w, 'a_log': a_log, 'dt_bias': dt_bias, 'gnorm_a': gnorm_a,
            'gnorm_b': gnorm_b, 'hgrn_lower_bounds': hgrn_lower_bounds,
            'w_branch_a': w_branch_a, 'w_branch_b': w_branch_b, 'w_out': w_out,
            'final_norm_w': final_norm_w}


def reference(x, meta_tokens, norm_w, w_in, conv_w, a_log, dt_bias, gnorm_a, gnorm_b,
              hgrn_lower_bounds, w_branch_a, w_branch_b, w_out, final_norm_w):
    b = x.shape[0]
    meta = jnp.broadcast_to(meta_tokens.astype(x.dtype)[None], (b, N_META, D_MODEL))
    h = jnp.concatenate([meta, x], axis=1)
    lb_sm = jax.nn.softmax(hgrn_lower_bounds.astype(jnp.float32), axis=0)
    lb_all = jnp.cumsum(lb_sm, axis=0) - lb_sm[0]
    for l in range(DEPTH):
        h = _layer(h, norm_w[l], w_in[l], conv_w[l], a_log[l], dt_bias[l], gnorm_a[l],
                   gnorm_b[l], lb_all[l], w_branch_a[l], w_branch_b[l], w_out[l])
    return _rmsnorm(h, final_norm_w)[:, N_META:]
```

```cpp
#include <hip/hip_runtime.h>
#include <hip/hip_cooperative_groups.h>
#include <cstdio>
namespace cg = cooperative_groups;

#ifndef PROBE_SCAN
#define PROBE_SCAN 0
#endif
#ifndef PROBE_G1
#define PROBE_G1 0
#endif
#ifndef MEGA
#define MEGA 1
#endif

#define LAS __attribute__((address_space(3)))
typedef unsigned short bf16_t;
typedef short bf16x8 __attribute__((ext_vector_type(8)));
typedef float f32x4 __attribute__((ext_vector_type(4)));
typedef unsigned u32x4 __attribute__((ext_vector_type(4)));
typedef unsigned u32x2 __attribute__((ext_vector_type(2)));

constexpr int DM = 1024, NBATCH = 32, SEQ = 2048, NMETA = 16, TT = SEQ + NMETA, MROWS = NBATCH * TT, NP = 6144, WIN = 6152;
constexpr float EPS = 1e-6f;
constexpr int NREAL = NBATCH * SEQ;
constexpr int C_AQ = 0, C_AK = 512, C_AV = 1024, C_BQ = 1536, C_BF = 2048, C_BI = 2560, C_AZ = 3072, C_BG = 3584, C_GA = 4096, C_GB = 5120;
constexpr size_t OFF_PROJ = 0;
constexpr size_t OFF_HB = OFF_PROJ + (size_t)MROWS * NP * 2;
constexpr size_t OFF_W1T = OFF_HB + (size_t)MROWS * DM * 2;
constexpr size_t OFF_W23T = OFF_W1T + (size_t)2 * NP * DM * 2;
constexpr size_t OFF_W4T = OFF_W23T + (size_t)2 * DM * DM * 2;
constexpr size_t OFF_W8 = OFF_W4T + (size_t)2 * DM * DM * 2;
constexpr size_t OFF_SUMSQ = OFF_W8 + (size_t)2 * 8 * DM * 4;
constexpr size_t OFF_BG = OFF_SUMSQ + (size_t)3 * MROWS * 4;
constexpr size_t OFF_HMETA = OFF_BG + (size_t)MROWS * 8 * 4;
constexpr size_t OFF_VB = OFF_HMETA + (size_t)NBATCH * NMETA * DM * 4;
constexpr size_t OFF_XBAR = OFF_VB + (size_t)MROWS * 512 * 2;
constexpr size_t WS_END = OFF_XBAR + 16384;
constexpr int LDS_BYTES = 133120;

struct Params {
    const float *x, *meta, *norm_w, *w_in, *conv_w, *a_log, *dt_bias, *gnorm_a, *gnorm_b, *lbraw, *wba, *wbb, *wout, *fnw;
    float* out;
    unsigned char* ws;
};

typedef __bf16 bf16x2_t __attribute__((ext_vector_type(2)));
__device__ __forceinline__ unsigned cvt_pk_bf16(float lo, float hi) { bf16x2_t v; v[0] = (__bf16)lo; v[1] = (__bf16)hi; return __builtin_bit_cast(unsigned, v); }
__device__ __forceinline__ bf16_t f2bf(float f) { return (bf16_t)(cvt_pk_bf16(f, 0.f) & 0xffffu); }
__device__ __forceinline__ float bflo(unsigned w) { return __uint_as_float(w << 16); }
__device__ __forceinline__ float bfhi(unsigned w) { return __uint_as_float(w & 0xffff0000u); }
__device__ __forceinline__ void unpack8(const u32x4 w, float (&o)[8]) {
    o[0] = bflo(w.x); o[1] = bfhi(w.x); o[2] = bflo(w.y); o[3] = bfhi(w.y); o[4] = bflo(w.z); o[5] = bfhi(w.z); o[6] = bflo(w.w); o[7] = bfhi(w.w);
}
__device__ __forceinline__ u32x4 pack8(const float (&v)[8]) {
    u32x4 w; w.x = cvt_pk_bf16(v[0], v[1]); w.y = cvt_pk_bf16(v[2], v[3]); w.z = cvt_pk_bf16(v[4], v[5]); w.w = cvt_pk_bf16(v[6], v[7]); return w;
}
__device__ __forceinline__ float sigmoidf_(float x) { return __builtin_amdgcn_rcpf(1.0f + __expf(-x)); }
__device__ __forceinline__ float siluf_(float x) { return x * __builtin_amdgcn_rcpf(1.0f + __expf(-x)); }
__device__ __forceinline__ float softplusf_(float x) { return fmaxf(x, 0.f) + log1pf(__expf(-fabsf(x))); }
__device__ __forceinline__ float wave_sum(float v) {
#pragma unroll
    for (int o = 1; o < 64; o <<= 1) v += __shfl_xor(v, o);
    return v;
}
__device__ __forceinline__ size_t rowof(int b, int t) { return t < NMETA ? (size_t)(NREAL + b * NMETA + t) : (size_t)b * SEQ + (size_t)(t - NMETA); }
#define LDS_WAIT() asm volatile("s_waitcnt lgkmcnt(0)" ::: "memory")
#define BAR_LDS() do { asm volatile("s_waitcnt lgkmcnt(0)" ::: "memory"); __builtin_amdgcn_s_barrier(); asm volatile("" ::: "memory"); } while (0)
__device__ __forceinline__ int otid() { int t = threadIdx.x; asm volatile("" : "+v"(t)); return t; }
__device__ __forceinline__ int obid() { int t = blockIdx.x; asm volatile("" : "+s"(t)); return t; }
__device__ __forceinline__ int ogrid() { int t = gridDim.x; asm volatile("" : "+s"(t)); return t; }

template <int KT>
__device__ __forceinline__ f32x4 mma_tile(f32x4 acc, const LAS bf16_t* A, int lda, const LAS bf16_t* B, int ldb, int r, int q) {
#pragma unroll
    for (int kk = 0; kk < KT; kk += 32) {
        const bf16x8 a = *(const LAS bf16x8*)(A + r * lda + kk + q * 8);
        const bf16x8 b = *(const LAS bf16x8*)(B + r * ldb + kk + q * 8);
        acc = __builtin_amdgcn_mfma_f32_16x16x32_bf16(a, b, acc, 0, 0, 0);
    }
    return acc;
}

typedef short s16x4 __attribute__((ext_vector_type(4)));
__device__ __forceinline__ bf16x8 frag_tr(const LAS bf16_t* T, int ld, int kbase, int cbase, int lane) {
    const int g = lane >> 4, qq = (lane & 15) >> 2, pp = lane & 3;
    const LAS bf16_t* p0 = T + (kbase + 8 * g + qq) * ld + cbase + 4 * pp;
    const s16x4 a = __builtin_amdgcn_ds_read_tr16_b64_v4i16((LAS s16x4*)p0);
    const s16x4 b = __builtin_amdgcn_ds_read_tr16_b64_v4i16((LAS s16x4*)(p0 + 4 * ld));
    return (bf16x8){a[0], a[1], a[2], a[3], b[0], b[1], b[2], b[3]};
}
template <int KT>
__device__ __forceinline__ f32x4 mma_tile_trB(f32x4 acc, const LAS bf16_t* A, int lda, const LAS bf16_t* Tb, int ldb, int n0, int lane) {
    const int r = lane & 15, q = lane >> 4;
#pragma unroll
    for (int kk = 0; kk < KT; kk += 32) {
        const bf16x8 a = *(const LAS bf16x8*)(A + r * lda + kk + q * 8);
        const bf16x8 b = frag_tr(Tb, ldb, kk, n0, lane);
        acc = __builtin_amdgcn_mfma_f32_16x16x32_bf16(a, b, acc, 0, 0, 0);
    }
    return acc;
}
template <int KT>
__device__ __forceinline__ f32x4 mma_tile_trA(f32x4 acc, const LAS bf16_t* Ta, int lda, int m0, const LAS bf16_t* B, int ldb, int lane) {
    const int r = lane & 15, q = lane >> 4;
#pragma unroll
    for (int kk = 0; kk < KT; kk += 32) {
        const bf16x8 a = frag_tr(Ta, lda, kk, m0, lane);
        const bf16x8 b = *(const LAS bf16x8*)(B + r * ldb + kk + q * 8);
        acc = __builtin_amdgcn_mfma_f32_16x16x32_bf16(a, b, acc, 0, 0, 0);
    }
    return acc;
}
template <int KT>
__device__ __forceinline__ f32x4 mma_tile_trAB(f32x4 acc, const LAS bf16_t* Ta, int lda, int m0, const LAS bf16_t* Tb, int ldb, int n0, int lane) {
#pragma unroll
    for (int kk = 0; kk < KT; kk += 32) {
        const bf16x8 a = frag_tr(Ta, lda, kk, m0, lane);
        const bf16x8 b = frag_tr(Tb, ldb, kk, n0, lane);
        acc = __builtin_amdgcn_mfma_f32_16x16x32_bf16(a, b, acc, 0, 0, 0);
    }
    return acc;
}

namespace pg8 {
constexpr int BM = 256, BK = 64, HALF = 128, HTB = HALF * BK * 2, NXCD = 8, WGM = 8;
__device__ __forceinline__ int lds_byte(int r, int c) { const int st = (r >> 4) * 2 + (c >> 5), rr = r & 15, cc = c & 31, ob = rr * 64 + cc * 2; return st * 1024 + (ob ^ (((ob >> 9) & 1) << 5)); }
__device__ __forceinline__ void stage_rc(int b, int& R, int& C) { const int st = b / 1024, sb = b % 1024, swz = sb ^ (((sb >> 9) & 1) << 5); R = (st >> 1) * 16 + swz / 64; C = (st & 1) * 32 + (swz % 64) / 2; }
__device__ __forceinline__ int perm32(int rho) { const int n = rho >> 4, i = rho & 15; return 8 * (i >> 2) + 4 * n + (i & 3); }
struct Unit { int pm, pn; };
struct Gemm { const bf16_t* A; const bf16_t* Bt; int M, N, K, lda, ldb; };
struct StaticOrder {
    int nM, nN, nwg, G, c;
    __device__ void init(int M, int N, int G_, int c_) { nM = M / BM; nN = N / BM; nwg = nM * nN; G = G_; c = c_; }
    __device__ bool next(int i, Unit& u) const {
        const long L = (long)i * G + c; if (L >= nwg) return false;
        int wgid = (int)L; { const int q = nwg / NXCD, r = nwg % NXCD, xcd = wgid % NXCD, off = wgid / NXCD; wgid = (xcd < r ? xcd * (q + 1) : r * (q + 1) + (xcd - r) * q) + off; }
        const int nig = WGM * nN, gid = wgid / nig, fm = gid * WGM, gsz = (nM - fm) < WGM ? (nM - fm) : WGM;
        u.pm = fm + ((wgid % nig) % gsz); u.pn = (wgid % nig) / gsz; return true;
    }
};

template <class Epi>
__device__ __forceinline__ void gemm_phase(LAS unsigned char* lds, const Gemm g, const StaticOrder& S, const Epi& E) {
    const int tid = otid(), wid = __builtin_amdgcn_readfirstlane(tid >> 6), lane = tid & 63, wr = wid >> 2, wc = wid & 3, fr = lane & 15, fq = lane >> 4;
    const int K = g.K, nt = K / BK;
    unsigned voffA[2], voffB[2];
#pragma unroll
    for (int i = 0; i < 2; ++i) { int R, C; stage_rc(tid * 16 + i * 8192, R, C); const int Rb = (R & ~31) + perm32(R & 31);
        voffA[i] = (unsigned)(R * g.lda + C) * 2u; voffB[i] = (unsigned)(Rb * g.ldb + C) * 2u; }
    const size_t kstep = (size_t)(BK * 2);
    const size_t hstepA = (size_t)HALF * g.lda * 2, hstepB = (size_t)HALF * g.ldb * 2;
    const size_t tstepA = 2 * hstepA, tstepB = 2 * hstepB;
    const unsigned ldsw = (unsigned)wid * 1024u;
    const int aoff = lds_byte(wr * 64 + fr, fq * 8), boff = lds_byte(wc * 32 + fr, fq * 8);
#define PG8_SA(b, h) (((b) * 2 + (h)) * HTB)
#define PG8_SB(b, h) ((4 + (b) * 2 + (h)) * HTB)
#define PG8_STAGE(bufoff, gbase, voff) do { _Pragma("unroll") for (int _i = 0; _i < 2; ++_i) \
        __builtin_amdgcn_global_load_lds((const unsigned*)((const char*)(gbase) + (voff)[_i]), (LAS unsigned*)(lds + (bufoff) + ldsw + _i * 8192), 16, 0, 0); } while (0)
#define PG8_LDA(dst, b, h) do { _Pragma("unroll") for (int m = 0; m < 4; ++m) _Pragma("unroll") for (int k = 0; k < 2; ++k) dst[m][k] = *(const LAS bf16x8*)(lds + PG8_SA(b, h) + aoff + m * 2048 + k * 1024); } while (0)
#define PG8_LDB(dst, b, h) do { _Pragma("unroll") for (int n = 0; n < 2; ++n) _Pragma("unroll") for (int k = 0; k < 2; ++k) dst[n][k] = *(const LAS bf16x8*)(lds + PG8_SB(b, h) + boff + n * 2048 + k * 1024); } while (0)
#define PG8_MMA(ai, bj, At, Bt) do { __builtin_amdgcn_s_setprio(1); _Pragma("unroll") for (int m = 0; m < 4; ++m) _Pragma("unroll") for (int n = 0; n < 2; ++n) _Pragma("unroll") for (int k = 0; k < 2; ++k) \
        acc[ai][bj][m][n] = __builtin_amdgcn_mfma_f32_16x16x32_bf16(Bt[n][k], At[m][k], acc[ai][bj][m][n], 0, 0, 0); __builtin_amdgcn_s_setprio(0); } while (0)
#define PG8_WAIT_V(n) asm volatile("s_waitcnt vmcnt(" #n ")" ::: "memory")
#define PG8_WAIT_L(n) asm volatile("s_waitcnt lgkmcnt(" #n ")" ::: "memory")
#define PG8_BAR __builtin_amdgcn_s_barrier()
#define PG8_SCHED __builtin_amdgcn_sched_barrier(0)
    Unit cur, nxt; int ui = 0;
    if (!S.next(0, cur)) return;
    f32x4 acc[2][2][4][2];
#pragma unroll
    for (int a = 0; a < 2; ++a)
#pragma unroll
        for (int b = 0; b < 2; ++b)
#pragma unroll
            for (int m = 0; m < 4; ++m)
#pragma unroll
                for (int n = 0; n < 2; ++n) acc[a][b][m][n] = (f32x4){0.f, 0.f, 0.f, 0.f};
    bf16x8 At[4][2], B0[2][2], B1[2][2];
    const char* cA = (const char*)g.A + (size_t)cur.pm * tstepA; const char* cB = (const char*)g.Bt + (size_t)cur.pn * tstepB;
    PG8_STAGE(PG8_SB(0, 0), cB, voffB); PG8_STAGE(PG8_SA(0, 0), cA, voffA); PG8_STAGE(PG8_SB(0, 1), cB + hstepB, voffB); PG8_STAGE(PG8_SA(0, 1), cA + hstepA, voffA);
    if (wr == 1) PG8_BAR;
    PG8_WAIT_V(4); PG8_BAR;
    PG8_STAGE(PG8_SB(1, 0), cB + kstep, voffB); PG8_STAGE(PG8_SA(1, 0), cA + kstep, voffA); PG8_STAGE(PG8_SB(1, 1), cB + hstepB + kstep, voffB);
    PG8_WAIT_V(6); PG8_BAR;
    for (;;) {
        const bool has_next = S.next(ui + 1, nxt);
        const char* nA = has_next ? (const char*)g.A + (size_t)nxt.pm * tstepA : cA; const char* nB = has_next ? (const char*)g.Bt + (size_t)nxt.pn * tstepB : cB;
        for (int t = 0; t < nt; t += 2) {
            const bool last = (t == nt - 2);
            const char* a1 = cA + (size_t)(t + 1) * kstep;
            const char* a2 = last ? nA : cA + (size_t)(t + 2) * kstep; const char* b2 = last ? nB : cB + (size_t)(t + 2) * kstep;
            const char* a3 = a2 + kstep; const char* b3 = b2 + kstep;
            PG8_LDB(B0, 0, 0); PG8_SCHED; PG8_LDA(At, 0, 0); PG8_STAGE(PG8_SA(1, 1), a1 + hstepA, voffA);
            PG8_WAIT_L(8); PG8_BAR; PG8_WAIT_L(0); PG8_MMA(0, 0, At, B0); PG8_BAR; PG8_SCHED;
            PG8_LDB(B1, 0, 1); PG8_STAGE(PG8_SB(0, 0), b2, voffB);
            PG8_BAR; PG8_WAIT_L(0); PG8_MMA(0, 1, At, B1); PG8_BAR;
            PG8_LDA(At, 0, 1); PG8_STAGE(PG8_SA(0, 0), a2, voffA);
            PG8_BAR; PG8_WAIT_L(0); PG8_MMA(1, 0, At, B0); PG8_BAR; PG8_SCHED;
            PG8_STAGE(PG8_SB(0, 1), b2 + hstepB, voffB);
            PG8_WAIT_V(6); PG8_BAR; PG8_MMA(1, 1, At, B1); PG8_BAR;
            PG8_LDB(B0, 1, 0); PG8_SCHED; PG8_LDA(At, 1, 0); PG8_STAGE(PG8_SA(0, 1), a2 + hstepA, voffA);
            PG8_WAIT_L(8); PG8_BAR; PG8_WAIT_L(0); PG8_MMA(0, 0, At, B0); PG8_BAR; PG8_SCHED;
            PG8_LDB(B1, 1, 1); PG8_STAGE(PG8_SB(1, 0), b3, voffB);
            PG8_BAR; PG8_WAIT_L(0); PG8_MMA(0, 1, At, B1); PG8_BAR;
            PG8_LDA(At, 1, 1); PG8_STAGE(PG8_SA(1, 0), a3, voffA);
            PG8_BAR; PG8_WAIT_L(0); PG8_MMA(1, 0, At, B0); PG8_BAR; PG8_SCHED;
            PG8_STAGE(PG8_SB(1, 1), b3 + hstepB, voffB);
            PG8_WAIT_V(6); PG8_BAR; PG8_MMA(1, 1, At, B1); PG8_BAR;
        }
        E(acc, cur, wr, wc, fr, fq);
        if (!has_next) break;
#pragma unroll
        for (int a = 0; a < 2; ++a)
#pragma unroll
            for (int b = 0; b < 2; ++b)
#pragma unroll
                for (int m = 0; m < 4; ++m)
#pragma unroll
                    for (int n = 0; n < 2; ++n) acc[a][b][m][n] = (f32x4){0.f, 0.f, 0.f, 0.f};
        cur = nxt; cA = nA; cB = nB; ++ui;
    }
    PG8_WAIT_V(0);
    if (wr == 0) PG8_BAR;
    PG8_BAR;
#undef PG8_SA
#undef PG8_SB
#undef PG8_STAGE
#undef PG8_LDA
#undef PG8_LDB
#undef PG8_MMA
#undef PG8_WAIT_V
#undef PG8_WAIT_L
#undef PG8_BAR
#undef PG8_SCHED
}

typedef f32x4 Acc[2][2][4][2];

struct EpiProj {
    static constexpr bool HAS_MID = false;
    bf16_t* O; const float* sumsq;
    __device__ __forceinline__ void operator()(const Acc& acc, const Unit& u, int wr, int wc, int fr, int fq) const {
        const int row0 = u.pm * BM + wr * 64 + fr, col0 = u.pn * BM + wc * 32 + 8 * fq;
        float ssq[2][4];
#pragma unroll
        for (int ai = 0; ai < 2; ++ai)
#pragma unroll
            for (int m = 0; m < 4; ++m) ssq[ai][m] = sumsq[row0 + ai * HALF + m * 16];
        __builtin_amdgcn_sched_barrier(0);
#pragma unroll
        for (int ai = 0; ai < 2; ++ai)
#pragma unroll
            for (int m = 0; m < 4; ++m) {
                const int row = row0 + ai * HALF + m * 16;
                const float rs = rsqrtf(ssq[ai][m] * (1.0f / DM) + EPS);
                bf16_t* rowp = O + (size_t)row * NP + col0;
#pragma unroll
                for (int bj = 0; bj < 2; ++bj) {
                    const f32x4 v0 = acc[ai][bj][m][0] * rs, v1 = acc[ai][bj][m][1] * rs;
                    u32x4 w; w.x = cvt_pk_bf16(v0[0], v0[1]); w.y = cvt_pk_bf16(v0[2], v0[3]); w.z = cvt_pk_bf16(v1[0], v1[1]); w.w = cvt_pk_bf16(v1[2], v1[3]);
                    __builtin_nontemporal_store(w, (u32x4*)(rowp + bj * HALF));
                }
            }
    }
};
#define EPI_SB() __builtin_amdgcn_sched_barrier(0)
template <int SECOND>
struct EpiMix {
    static constexpr bool HAS_MID = false;
    bf16_t* proj;
    template <int AIM> __device__ __forceinline__ void load_q(u32x4 (&wg)[2][2], u32x4 (&wp)[2][2], int row0, int col0) const {
        constexpr int ai = AIM >> 1, m0 = (AIM & 1) * 2;
#pragma unroll
        for (int mm = 0; mm < 2; ++mm) {
            const bf16_t* rowp = proj + (size_t)(row0 + ai * HALF + (m0 + mm) * 16) * NP + col0;
#pragma unroll
            for (int bj = 0; bj < 2; ++bj) {
                wg[mm][bj] = *(const u32x4*)(rowp + (SECOND ? C_GB : C_GA) + bj * HALF);
                if (SECOND) wp[mm][bj] = *(const u32x4*)(rowp + bj * HALF); else wp[mm][bj] = (u32x4){0u, 0u, 0u, 0u};
            }
        }
    }
    template <int AIM> __device__ __forceinline__ void proc_q(const Acc& acc, const u32x4 (&wg)[2][2], const u32x4 (&wp)[2][2], int row0, int col0) const {
        constexpr int ai = AIM >> 1, m0 = (AIM & 1) * 2;
#pragma unroll
        for (int mm = 0; mm < 2; ++mm) {
            bf16_t* rowp = proj + (size_t)(row0 + ai * HALF + (m0 + mm) * 16) * NP + col0;
#pragma unroll
            for (int bj = 0; bj < 2; ++bj) {
                float gt[8], o[8]; unpack8(wg[mm][bj], gt); unpack8(wp[mm][bj], o);
#pragma unroll
                for (int e = 0; e < 8; ++e) o[e] += acc[ai][bj][m0 + mm][e >> 2][e & 3] * sigmoidf_(gt[e]);
                *(u32x4*)(rowp + bj * HALF) = pack8(o);
            }
        }
    }
    __device__ __forceinline__ void operator()(const Acc& acc, const Unit& u, int wr, int wc, int fr, int fq) const {
        const int row0 = u.pm * BM + wr * 64 + fr, col0 = u.pn * BM + wc * 32 + 8 * fq;
        u32x4 g0[2][2], p0[2][2], g1[2][2], p1[2][2];
        load_q<0>(g0, p0, row0, col0); load_q<1>(g1, p1, row0, col0); EPI_SB();
        proc_q<0>(acc, g0, p0, row0, col0); EPI_SB(); load_q<2>(g0, p0, row0, col0); EPI_SB();
        proc_q<1>(acc, g1, p1, row0, col0); EPI_SB(); load_q<3>(g1, p1, row0, col0); EPI_SB();
        proc_q<2>(acc, g0, p0, row0, col0); EPI_SB();
        proc_q<3>(acc, g1, p1, row0, col0); EPI_SB();
    }
};
struct EpiOut {
    static constexpr bool HAS_MID = false;
    int layer; const float* x; const float* meta; float* out; float* hmeta; bf16_t* hb; float* sumsq_next;
    template <int AIM> __device__ __forceinline__ void load_r(f32x4 (&rr)[2][2], int row0, int col0) const {
        constexpr int ai = AIM >> 2, m = AIM & 3;
        const int row = row0 + ai * HALF + m * 16;
        const bool ism = row >= NREAL; const int idx = ism ? row - NREAL : 0;
        const float* rp;
        if (layer == 0) rp = ism ? meta + (size_t)(idx & (NMETA - 1)) * DM : x + (size_t)row * DM;
        else rp = ism ? hmeta + (size_t)idx * DM : out + (size_t)row * DM;
#pragma unroll
        for (int bj = 0; bj < 2; ++bj) { const int c = col0 + bj * HALF; rr[bj][0] = *(const f32x4*)(rp + c); rr[bj][1] = *(const f32x4*)(rp + c + 4); }
    }
    template <int AIM> __device__ __forceinline__ void proc_r(const Acc& acc, const f32x4 (&rr)[2][2], int row0, int col0, int fq) const {
        constexpr int ai = AIM >> 2, m = AIM & 3;
        const int row = row0 + ai * HALF + m * 16;
        const bool ism = row >= NREAL; const int idx = ism ? row - NREAL : 0;
        float* wp = ism ? hmeta + (size_t)idx * DM : out + (size_t)row * DM;
        const bool do_store = (layer == 0) || !ism;
        float ss = 0.f;
#pragma unroll
        for (int bj = 0; bj < 2; ++bj) {
            const int c = col0 + bj * HALF;
            const f32x4 v0 = acc[ai][bj][m][0] + rr[bj][0], v1 = acc[ai][bj][m][1] + rr[bj][1];
            if (do_store) { *(f32x4*)(wp + c) = v0; *(f32x4*)(wp + c + 4) = v1; }
            if (layer == 0) { u32x4 w; w.x = cvt_pk_bf16(v0[0], v0[1]); w.y = cvt_pk_bf16(v0[2], v0[3]); w.z = cvt_pk_bf16(v1[0], v1[1]); w.w = cvt_pk_bf16(v1[2], v1[3]);
                *(u32x4*)(hb + (size_t)row * DM + c) = w; }
            ss += (v0[0] * v0[0] + v0[1] * v0[1]) + (v0[2] * v0[2] + v0[3] * v0[3]) + (v1[0] * v1[0] + v1[1] * v1[1]) + (v1[2] * v1[2] + v1[3] * v1[3]);
        }
        ss += __shfl_xor(ss, 16); ss += __shfl_xor(ss, 32);
        if (fq == 0) atomicAdd(sumsq_next + row, ss);
    }
    __device__ __forceinline__ void operator()(const Acc& acc, const Unit& u, int wr, int wc, int fr, int fq) const {
        const int row0 = u.pm * BM + wr * 64 + fr, col0 = u.pn * BM + wc * 32 + 8 * fq;
        f32x4 r0[2][2], r1[2][2];
        load_r<0>(r0, row0, col0); load_r<1>(r1, row0, col0); EPI_SB();
        proc_r<0>(acc, r0, row0, col0, fq); EPI_SB(); load_r<2>(r0, row0, col0); EPI_SB();
        proc_r<1>(acc, r1, row0, col0, fq); EPI_SB(); load_r<3>(r1, row0, col0); EPI_SB();
        proc_r<2>(acc, r0, row0, col0, fq); EPI_SB(); load_r<4>(r0, row0, col0); EPI_SB();
        proc_r<3>(acc, r1, row0, col0, fq); EPI_SB(); load_r<5>(r1, row0, col0); EPI_SB();
        proc_r<4>(acc, r0, row0, col0, fq); EPI_SB(); load_r<6>(r0, row0, col0); EPI_SB();
        proc_r<5>(acc, r1, row0, col0, fq); EPI_SB(); load_r<7>(r1, row0, col0); EPI_SB();
        proc_r<6>(acc, r0, row0, col0, fq); EPI_SB();
        proc_r<7>(acc, r1, row0, col0, fq); EPI_SB();
    }
};
}

__device__ __forceinline__ void transpose_item(const float* W, int ldw, const float* scale, bf16_t* WT, int ldt, LAS float* scr, int lane) {
    float tv[32];
#pragma unroll
    for (int i = 0; i < 32; ++i) { const int kk = 2 * i + (lane >> 5); tv[i] = W[(size_t)kk * ldw + (lane & 31)]; }
#pragma unroll
    for (int i = 0; i < 32; ++i) { const int kk = 2 * i + (lane >> 5); scr[kk * 33 + (lane & 31)] = tv[i] * (scale ? scale[kk] : 1.0f); }
    LDS_WAIT();
    const int c = lane & 7;
#pragma unroll
    for (int j = 0; j < 4; ++j) { const int n = (lane >> 3) + 8 * j; const LAS float* s = scr + (8 * c) * 33 + n;
        u32x4 o; o.x = cvt_pk_bf16(s[0 * 33], s[1 * 33]); o.y = cvt_pk_bf16(s[2 * 33], s[3 * 33]); o.z = cvt_pk_bf16(s[4 * 33], s[5 * 33]); o.w = cvt_pk_bf16(s[6 * 33], s[7 * 33]);
        *(u32x4*)(WT + (size_t)n * ldt + 8 * c) = o; }
    LDS_WAIT();
}
__device__ __forceinline__ int orig_col(int n) { return n < 1536 ? n : (n < 3072 ? n + 520 : (n < 3584 ? n - 1528 : n + 8)); }

__device__ __forceinline__ void phase0(const Params& p, LAS unsigned char* lds) {
    const int tid = otid(), wave = tid >> 6, lane = tid & 63;
    const int gw = blockIdx.x * 8 + wave, NGW = gridDim.x * 8;
    LAS float* scr = (LAS float*)(lds + wave * 8448);
    bf16_t* W1T = (bf16_t*)(p.ws + OFF_W1T); bf16_t* W23T = (bf16_t*)(p.ws + OFF_W23T); bf16_t* W4T = (bf16_t*)(p.ws + OFF_W4T);
    for (int it = gw; it < 8192; it += NGW) {
        const int l = it >> 12; int r = it & 4095;
        if (r < 3072) { const int kb = r / 192, nb = r % 192, n0 = nb * 32, k0 = kb * 64;
            transpose_item(p.w_in + (size_t)l * DM * WIN + (size_t)k0 * WIN + orig_col(n0), WIN, p.norm_w + l * DM + k0, W1T + (size_t)l * NP * DM + (size_t)n0 * DM + k0, DM, scr, lane);
        } else if (r < 3584) { r -= 3072; const int kb = r / 32, nb = r % 32, n0 = nb * 32, k0 = kb * 64;
            const float* src = kb < 8 ? p.wba + (size_t)l * 512 * DM + (size_t)k0 * DM + n0 : p.wbb + (size_t)l * 512 * DM + (size_t)(k0 - 512) * DM + n0;
            transpose_item(src, DM, nullptr, W23T + (size_t)l * DM * DM + (size_t)n0 * DM + k0, DM, scr, lane);
        } else { r -= 3584; const int kb = r / 32, nb = r % 32, n0 = nb * 32, k0 = kb * 64;
            transpose_item(p.wout + (size_t)l * DM * DM + (size_t)k0 * DM + n0, DM, nullptr, W4T + (size_t)l * DM * DM + (size_t)n0 * DM + k0, DM, scr, lane);
        }
    }
    float* W8 = (float*)(p.ws + OFF_W8);
    for (int i = blockIdx.x * 512 + tid; i < 2 * 8 * DM; i += gridDim.x * 512) { const int l = i >> 13, j = (i >> 10) & 7, k = i & 1023;
        W8[i] = p.norm_w[l * DM + k] * p.w_in[(size_t)l * DM * WIN + (size_t)k * WIN + 1536 + j]; }
    bf16_t* hb = (bf16_t*)(p.ws + OFF_HB); float* sumsq = (float*)(p.ws + OFF_SUMSQ);
    auto row_src = [&](const int row) { return row < NREAL ? p.x + (size_t)row * DM : p.meta + (size_t)((row - NREAL) & (NMETA - 1)) * DM; };
    f32x4 vn[4];
    if (gw < MROWS) { const float* src = row_src(gw);
#pragma unroll
        for (int j = 0; j < 4; ++j) vn[j] = *(const f32x4*)(src + 4 * lane + 256 * j); }
    for (int row = gw; row < MROWS; row += NGW) {
        f32x4 v[4]; float s = 0.f;
#pragma unroll
        for (int j = 0; j < 4; ++j) v[j] = vn[j];
        if (row + NGW < MROWS) { const float* src = row_src(row + NGW);
#pragma unroll
            for (int j = 0; j < 4; ++j) vn[j] = *(const f32x4*)(src + 4 * lane + 256 * j); }
#pragma unroll
        for (int j = 0; j < 4; ++j) s += (v[j][0] * v[j][0] + v[j][1] * v[j][1]) + (v[j][2] * v[j][2] + v[j][3] * v[j][3]);
        s = wave_sum(s);
#pragma unroll
        for (int j = 0; j < 4; ++j) { u32x2 o; o.x = cvt_pk_bf16(v[j][0], v[j][1]); o.y = cvt_pk_bf16(v[j][2], v[j][3]); *(u32x2*)(hb + (size_t)row * DM + 4 * lane + 256 * j) = o; }
        if (lane == 0) { sumsq[row] = s; sumsq[MROWS + row] = 0.f; sumsq[2 * MROWS + row] = 0.f; }
    }
}

__device__ __forceinline__ void bg_pass(const Params& p, int l) {
    const int tid = otid(), wave = tid >> 6, lane = tid & 63;
    const int gw = blockIdx.x * 8 + wave, NGW = gridDim.x * 8;
    const float* W8 = (const float*)(p.ws + OFF_W8) + (size_t)l * 8 * DM;
    const bf16_t* hb = (const bf16_t*)(p.ws + OFF_HB); const float* sumsq = (const float*)(p.ws + OFF_SUMSQ) + (size_t)l * MROWS;
    float* bg = (float*)(p.ws + OFF_BG);
    float wr_[8][16];
#pragma unroll
    for (int j = 0; j < 8; ++j) {
        const f32x4 a0 = *(const f32x4*)(W8 + j * DM + 8 * lane), a1 = *(const f32x4*)(W8 + j * DM + 8 * lane + 4), b0 = *(const f32x4*)(W8 + j * DM + 512 + 8 * lane), b1 = *(const f32x4*)(W8 + j * DM + 512 + 8 * lane + 4);
#pragma unroll
        for (int e = 0; e < 4; ++e) { wr_[j][e] = a0[e]; wr_[j][4 + e] = a1[e]; wr_[j][8 + e] = b0[e]; wr_[j][12 + e] = b1[e]; }
    }
    const int jj = lane & 7, hh = jj & 3;
    const float alog = p.a_log[l * 4 + hh], dtb = p.dt_bias[l * 4 + hh];
    u32x4 n0 = (u32x4){0u, 0u, 0u, 0u}, n1 = n0; float nss = 0.f;
    if (gw < MROWS) { n0 = *(const u32x4*)(hb + (size_t)gw * DM + 8 * lane); n1 = *(const u32x4*)(hb + (size_t)gw * DM + 512 + 8 * lane); nss = sumsq[gw]; }
    for (int row = gw; row < MROWS; row += NGW) {
        const u32x4 w0 = n0, w1 = n1; const float css = nss;
        if (row + NGW < MROWS) { const size_t rn = (size_t)(row + NGW); n0 = *(const u32x4*)(hb + rn * DM + 8 * lane); n1 = *(const u32x4*)(hb + rn * DM + 512 + 8 * lane); nss = sumsq[rn]; }
        float hv[16]; { float t0[8], t1[8]; unpack8(w0, t0); unpack8(w1, t1);
#pragma unroll
            for (int e = 0; e < 8; ++e) { hv[e] = t0[e]; hv[8 + e] = t1[e]; } }
        float d[8];
#pragma unroll
        for (int j = 0; j < 8; ++j) { float s = 0.f;
#pragma unroll
            for (int e = 0; e < 16; ++e) s += hv[e] * wr_[j][e];
            d[j] = wave_sum(s); }
        const float rs = rsqrtf(css * (1.0f / DM) + EPS);
        float val = d[0];
#pragma unroll
        for (int j = 1; j < 8; ++j) val = (jj == j) ? d[j] : val;
        val *= rs;
        const float o = jj < 4 ? sigmoidf_(val) : -__expf(alog) * softplusf_(val + dtb);
        if (lane < 8) bg[(size_t)row * 8 + lane] = o;
    }
}

__device__ __forceinline__ void gdn_prep(const Params& p, int l, LAS unsigned char* lds) {
    const int tid = otid();
    const int tok = tid >> 4, cg8 = (tid & 15) * 8;
    LAS float* sCW = (LAS float*)lds;
    for (int i = tid; i < 4 * 3 * 4 * 128; i += 512) { const int h = i / 1536, rem = i - h * 1536, mat = rem >> 9, tap = (rem >> 7) & 3, c = rem & 127; sCW[i] = p.conv_w[(size_t)l * 4 * 1536 + tap * 1536 + mat * 512 + h * 128 + c]; }
    __syncthreads();
    const bf16_t* proj = (const bf16_t*)(p.ws + OFF_PROJ);
    bf16_t* qk = (bf16_t*)(p.ws + OFF_HB); bf16_t* vb = (bf16_t*)(p.ws + OFF_VB);
    constexpr int NIT = NBATCH * 65 * 4;
    const int G = ogrid();
    auto load_item = [&](const int it, u32x4 (&raw)[3][4]) {
        const int h = it & 3, bc = it >> 2, b = bc / 65, c = bc - b * 65;
        const int t = c * 32 + tok; const bool valid = t < TT;
#pragma unroll
        for (int mat = 0; mat < 3; ++mat)
#pragma unroll
            for (int tap = 0; tap < 4; ++tap) {
                const int ts = t - 3 + tap;
                raw[mat][tap] = (u32x4){0u, 0u, 0u, 0u};
                if (valid && ts >= 0) raw[mat][tap] = *(const u32x4*)(proj + rowof(b, ts) * NP + mat * 512 + h * 128 + cg8);
            }
    };
    auto compute_item = [&](const int it, const u32x4 (&rc)[3][4]) {
        const int h = it & 3, bc = it >> 2, b = bc / 65, c = bc - b * 65;
            const int t = c * 32 + tok; const bool valid = t < TT;
            float cv[3][8];
#pragma unroll
            for (int mat = 0; mat < 3; ++mat) {
#pragma unroll
                for (int e = 0; e < 8; ++e) cv[mat][e] = 0.f;
#pragma unroll
                for (int tap = 0; tap < 4; ++tap) {
                    float xr[8]; unpack8(rc[mat][tap], xr);
                    const f32x4 c0 = *(const LAS f32x4*)(sCW + h * 1536 + (mat * 4 + tap) * 128 + cg8), c1 = *(const LAS f32x4*)(sCW + h * 1536 + (mat * 4 + tap) * 128 + cg8 + 4);
#pragma unroll
                    for (int e = 0; e < 4; ++e) { cv[mat][e] += c0[e] * xr[e]; cv[mat][4 + e] += c1[e] * xr[4 + e]; }
                }
#pragma unroll
                for (int e = 0; e < 8; ++e) cv[mat][e] = siluf_(cv[mat][e]);
            }
            float sq = 0.f, sk = 0.f;
#pragma unroll
            for (int e = 0; e < 8; ++e) { sq += cv[0][e] * cv[0][e]; sk += cv[1][e] * cv[1][e]; }
#pragma unroll
            for (int o = 1; o < 16; o <<= 1) { sq += __shfl_xor(sq, o); sk += __shfl_xor(sk, o); }
            const float rq = rsqrtf(sq + EPS) * 0.08838834764831845f, rk = rsqrtf(sk + EPS);
#pragma unroll
            for (int e = 0; e < 8; ++e) { cv[0][e] *= rq; cv[1][e] *= rk; }
            if (valid) {
                const size_t row = rowof(b, t);
                *(u32x4*)(qk + row * DM + h * 128 + cg8) = pack8(cv[0]);
                *(u32x4*)(qk + row * DM + 512 + h * 128 + cg8) = pack8(cv[1]);
                *(u32x4*)(vb + row * 512 + h * 128 + cg8) = pack8(cv[2]);
            }
    };
    u32x4 r0[3][4], r1[3][4], r2[3][4];
    int it = obid();
    if (it < NIT) load_item(it, r0);
    if (it + G < NIT) load_item(it + G, r1);
    while (it < NIT) {
        if (it + 2 * G < NIT) load_item(it + 2 * G, r2);
        compute_item(it, r0); it += G; if (it >= NIT) break;
        if (it + 2 * G < NIT) load_item(it + 2 * G, r0);
        compute_item(it, r1); it += G; if (it >= NIT) break;
        if (it + 2 * G < NIT) load_item(it + 2 * G, r1);
        compute_item(it, r2); it += G;
    }
}

__device__ __forceinline__ void gdn_chain(const Params& p, int l, int b, int h, LAS unsigned char* lds, bool dummy = false) {
    const int tid = otid(), wave = tid >> 6, lane = tid & 63, r = lane & 15, q = lane >> 4;
    const int tok = tid >> 4, cg8 = (tid & 15) * 8;
    LAS bf16_t* sQ = (LAS bf16_t*)(lds + 0);
    LAS bf16_t* sK = (LAS bf16_t*)(lds + 8704);
    LAS bf16_t* sKb = (LAS bf16_t*)(lds + 17408);
    LAS bf16_t* sV = (LAS bf16_t*)(lds + 26112);
    LAS bf16_t* sVT = (LAS bf16_t*)(lds + 36352);
    LAS bf16_t* sVTs = (LAS bf16_t*)(lds + 46592);
    LAS bf16_t* sTb = (LAS bf16_t*)(lds + 56832);
    LAS bf16_t* sP = (LAS bf16_t*)(lds + 59392);
    LAS bf16_t* sSt = (LAS bf16_t*)(lds + 61952);
    LAS float* sAm = (LAS float*)(lds + 96768);
    LAS float* sO = (LAS float*)(lds + 101376);
    LAS float* sG = (LAS float*)(lds + 118272);
    LAS float* sCW = (LAS float*)(lds + 118400);
    LAS bf16_t* sA21 = (LAS bf16_t*)(lds + 124544);
    LAS bf16_t* sT11T = (LAS bf16_t*)(lds + 125824);
    LAS bf16_t* sT22 = (LAS bf16_t*)(lds + 127104);
    LAS bf16_t* sXT = (LAS bf16_t*)(lds + 128384);
    LAS bf16_t* sTbg = (LAS bf16_t*)(lds + 129664);
    LAS float* sBeta = (LAS float*)(lds + 132224);
    LAS float* sEgl = (LAS float*)(lds + 132352);
    bf16_t* proj = (bf16_t*)(p.ws + OFF_PROJ);
    const float* bg = (const float*)(p.ws + OFF_BG);
    for (int i = tid; i < 128 * 136 / 2; i += 512) ((LAS unsigned*)sSt)[i] = 0u;
    for (int i = tid; i < 4 * 16 * 40 / 2; i += 512) ((LAS unsigned*)sA21)[i] = 0u;
    for (int i = tid; i < 32 * 40 / 2; i += 512) { ((LAS unsigned*)sTb)[i] = 0u; ((LAS unsigned*)sTbg)[i] = 0u; }
    f32x4 Sacc[8];
#pragma unroll
    for (int i = 0; i < 8; ++i) Sacc[i] = (f32x4){0.f, 0.f, 0.f, 0.f};
    float gn[8];
#pragma unroll
    for (int e = 0; e < 8; ++e) gn[e] = p.gnorm_a[l * 128 + cg8 + e];
    __syncthreads();
    const size_t rowbase = (size_t)b * TT;
    const int tr = wave >> 2, vc0 = (wave & 3) * 2;
    const bf16_t* qkb = (const bf16_t*)(p.ws + OFF_HB); const bf16_t* vbb = (const bf16_t*)(p.ws + OFF_VB);
    u32x4 pq, pk, pv;
    { const size_t row = rowof(b, tok); pq = *(const u32x4*)(qkb + row * DM + h * 128 + cg8); pk = *(const u32x4*)(qkb + row * DM + 512 + h * 128 + cg8); pv = *(const u32x4*)(vbb + row * 512 + h * 128 + cg8); }
    float pgj = bg[rowof(b, (lane & 31)) * 8 + 4 + h], pbeta = bg[rowof(b, tok) * 8 + h];
    for (int c = 0; c < 65; ++c) {
        const int t0 = c * 32, t = t0 + tok; const bool valid = t < TT;
        float gj = pgj; const float beta = pbeta;
        { const int tj = t0 + 32 + (lane & 31), tn = t + 32; pgj = (tj < TT) ? bg[rowof(b, tj) * 8 + 4 + h] : 0.f; pbeta = (tn < TT) ? bg[rowof(b, tn) * 8 + h] : 0.f; }
#pragma unroll
        for (int d = 1; d < 32; d <<= 1) { const float tt = __shfl_up(gj, d, 32); if ((lane & 31) >= d) gj += tt; }
        const float Gt = __shfl(gj, tok, 64), glast = __shfl(gj, 31, 64);
        if (wave == 0 && lane < 32) sG[lane] = gj;
        bf16_t* const zp = proj + rowof(b, (valid ? t : 0)) * NP + C_AZ + h * 128 + cg8;
        const u32x4 zreg = *(const u32x4*)zp;
        {
            const u32x4 cq = pq, ck = pk, cvv = pv;
            const int tn = t + 32;
            pq = (u32x4){0u, 0u, 0u, 0u}; pk = pq; pv = pq;
            if (tn < TT) { const size_t row = rowof(b, tn); pq = *(const u32x4*)(qkb + row * DM + h * 128 + cg8); pk = *(const u32x4*)(qkb + row * DM + 512 + h * 128 + cg8); pv = *(const u32x4*)(vbb + row * 512 + h * 128 + cg8); }
            const float eGl = __expf(glast - Gt);
            *(LAS u32x4*)(sQ + tok * 136 + cg8) = cq;
            *(LAS u32x4*)(sK + tok * 136 + cg8) = ck;
            *(LAS u32x4*)(sV + tok * 136 + cg8) = cvv;
            if ((tid & 15) == 0) { sBeta[tok] = beta; sEgl[tok] = eGl; }
        }
        BAR_LDS();
        {
            const int w4 = wave & 3, ti = w4 >> 1, tj = w4 & 1;
            f32x4 a = (f32x4){0.f, 0.f, 0.f, 0.f};
            a = mma_tile<128>(a, (wave < 4 ? sK : sQ) + ti * 16 * 136, 136, sK + tj * 16 * 136, 136, r, q);
            const int jcol = tj * 16 + r; const float Gj = sG[jcol];
#pragma unroll
            for (int j = 0; j < 4; ++j) {
                const int i = ti * 16 + q * 4 + j; const float Gi = sG[i];
                const float dec = __expf(fminf(Gi - Gj, 0.f));
                if (wave < 4) { const float ab = a[j] * dec * sBeta[i]; sAm[jcol * 36 + i] = (i > jcol) ? ab : 0.f; if (w4 == 2) sA21[(i - 16) * 40 + jcol] = f2bf(ab); }
                else sP[i * 40 + jcol] = f2bf((i >= jcol) ? a[j] * dec : 0.f);
            }
        }
        BAR_LDS();
        if (wave == 0) {
            if (lane < 32) {
                const int blk = lane >> 4, cc = lane & 15;
                const LAS float* Ab = sAm + (16 * blk) * 36 + 16 * blk;
                const float bj = sBeta[16 * blk + cc], bgj = bj * __expf(sG[16 * blk + cc]);
                float xx[16];
#pragma unroll
                for (int i = 0; i < 16; ++i) xx[i] = (i == cc) ? 1.f : 0.f;
                f32x4 ar[2][4];
#pragma unroll
                for (int g = 0; g < 4; ++g) ar[0][g] = *(const volatile LAS f32x4*)(Ab + g * 4);
#pragma unroll
                for (int j = 0; j < 15; ++j) {
                    if (j + 1 < 15) {
#pragma unroll
                        for (int g = (j + 2) / 4; g < 4; ++g) ar[(j + 1) & 1][g] = *(const volatile LAS f32x4*)(Ab + (j + 1) * 36 + g * 4);
                    }
#pragma unroll
                    for (int i = j + 1; i < 16; ++i) xx[i] -= ar[j & 1][i >> 2][i & 3] * xx[j];
                }
#pragma unroll
                for (int i = 0; i < 16; ++i) { sTb[(16 * blk + i) * 40 + 16 * blk + cc] = f2bf(xx[i] * bj); sTbg[(16 * blk + i) * 40 + 16 * blk + cc] = f2bf(xx[i] * bgj); }
                if (blk == 0) {
                    float lo[8], hi[8];
#pragma unroll
                    for (int i = 0; i < 8; ++i) { lo[i] = xx[i]; hi[i] = xx[8 + i]; }
                    *(LAS u32x4*)(sT11T + cc * 40) = pack8(lo); *(LAS u32x4*)(sT11T + cc * 40 + 8) = pack8(hi);
                } else {
#pragma unroll
                    for (int i = 0; i < 16; ++i) sT22[i * 40 + cc] = f2bf(xx[i]);
                }
            }
            LDS_WAIT();
            const f32x4 X = mma_tile<32>((f32x4){0.f, 0.f, 0.f, 0.f}, sA21, 40, sT11T, 40, r, q);
            { u32x2 w; w.x = cvt_pk_bf16(X[0], X[1]); w.y = cvt_pk_bf16(X[2], X[3]); *(LAS u32x2*)(sXT + r * 40 + q * 4) = w; }
            LDS_WAIT();
            const f32x4 Y = mma_tile<32>((f32x4){0.f, 0.f, 0.f, 0.f}, sT22, 40, sXT, 40, r, q);
#pragma unroll
            for (int j = 0; j < 4; ++j) { const float bj = sBeta[r], bgj = bj * __expf(sG[r]); sTb[(16 + q * 4 + j) * 40 + r] = f2bf(-Y[j] * bj); sTbg[(16 + q * 4 + j) * 40 + r] = f2bf(-Y[j] * bgj); }
        }
        BAR_LDS();
        f32x4 au[2], ao[2];
        {
            const bf16x8 aTb = *(const LAS bf16x8*)(sTb + (tr * 16 + r) * 40 + q * 8), aTbg = *(const LAS bf16x8*)(sTbg + (tr * 16 + r) * 40 + q * 8);
#pragma unroll
            for (int x = 0; x < 2; ++x) {
                const int vc = vc0 + x;
                au[x] = __builtin_amdgcn_mfma_f32_16x16x32_bf16(aTb, frag_tr(sV, 136, 0, vc * 16, lane), (f32x4){0.f, 0.f, 0.f, 0.f}, 0, 0, 0);
                const f32x4 aw = __builtin_amdgcn_mfma_f32_16x16x32_bf16(aTbg, frag_tr(sK, 136, 0, vc * 16, lane), (f32x4){0.f, 0.f, 0.f, 0.f}, 0, 0, 0);
#pragma unroll
                for (int j = 0; j < 4; ++j) sKb[(tr * 16 + q * 4 + j) * 136 + vc * 16 + r] = f2bf(-aw[j]);
            }
        }
        BAR_LDS();
        {
            bf16x8 aW[4], aQ[4];
#pragma unroll
            for (int kk = 0; kk < 4; ++kk) { aW[kk] = *(const LAS bf16x8*)(sKb + (tr * 16 + r) * 136 + kk * 32 + q * 8); aQ[kk] = *(const LAS bf16x8*)(sQ + (tr * 16 + r) * 136 + kk * 32 + q * 8); }
            const f32x4 gi = *(const LAS f32x4*)(sG + tr * 16 + q * 4);
            const f32x4 eg = *(const LAS f32x4*)(sEgl + tr * 16 + q * 4);
#pragma unroll
            for (int x = 0; x < 2; ++x) {
                const int vc = vc0 + x;
                ao[x] = (f32x4){0.f, 0.f, 0.f, 0.f};
#pragma unroll
                for (int kk = 0; kk < 4; ++kk) {
                    const bf16x8 bS = *(const LAS bf16x8*)(sSt + (vc * 16 + r) * 136 + kk * 32 + q * 8);
                    au[x] = __builtin_amdgcn_mfma_f32_16x16x32_bf16(aW[kk], bS, au[x], 0, 0, 0);
                    ao[x] = __builtin_amdgcn_mfma_f32_16x16x32_bf16(aQ[kk], bS, ao[x], 0, 0, 0);
                }
#pragma unroll
                for (int j = 0; j < 4; ++j) ao[x][j] *= __expf(gi[j]);
                u32x2 w; w.x = cvt_pk_bf16(au[x][0], au[x][1]); w.y = cvt_pk_bf16(au[x][2], au[x][3]);
                *(LAS u32x2*)(sVT + (vc * 16 + r) * 40 + tr * 16 + q * 4) = w;
                u32x2 ws; ws.x = cvt_pk_bf16(au[x][0] * eg[0], au[x][1] * eg[1]); ws.y = cvt_pk_bf16(au[x][2] * eg[2], au[x][3] * eg[3]);
                *(LAS u32x2*)(sVTs + (vc * 16 + r) * 40 + tr * 16 + q * 4) = ws;
            }
        }
        BAR_LDS();
        {
            const bf16x8 aP = *(const LAS bf16x8*)(sP + (tr * 16 + r) * 40 + q * 8);
#pragma unroll
            for (int x = 0; x < 2; ++x) {
                const int vc = vc0 + x;
                const bf16x8 bV = *(const LAS bf16x8*)(sVT + (vc * 16 + r) * 40 + q * 8);
                ao[x] = __builtin_amdgcn_mfma_f32_16x16x32_bf16(aP, bV, ao[x], 0, 0, 0);
#pragma unroll
                for (int j = 0; j < 4; ++j) sO[(tr * 16 + q * 4 + j) * 132 + vc * 16 + r] = ao[x][j];
            }
        }
        {
            const float egl = __expf(glast);
            const bf16x8 bVs = *(const LAS bf16x8*)(sVTs + (wave * 16 + r) * 40 + q * 8);
            bf16x8 aK[8];
#pragma unroll
            for (int kr = 0; kr < 8; ++kr) aK[kr] = frag_tr(sK, 136, 0, kr * 16, lane);
#pragma unroll
            for (int kr = 0; kr < 8; ++kr) {
                Sacc[kr] = Sacc[kr] * egl;
                Sacc[kr] = __builtin_amdgcn_mfma_f32_16x16x32_bf16(aK[kr], bVs, Sacc[kr], 0, 0, 0);
                u32x2 w; w.x = cvt_pk_bf16(Sacc[kr][0], Sacc[kr][1]); w.y = cvt_pk_bf16(Sacc[kr][2], Sacc[kr][3]);
                *(LAS u32x2*)(sSt + (wave * 16 + r) * 136 + kr * 16 + q * 4) = w;
            }
        }
        BAR_LDS();
        {
            const f32x4 o0 = *(const LAS f32x4*)(sO + tok * 132 + cg8), o1 = *(const LAS f32x4*)(sO + tok * 132 + cg8 + 4);
            float ss = (o0[0] * o0[0] + o0[1] * o0[1]) + (o0[2] * o0[2] + o0[3] * o0[3]) + (o1[0] * o1[0] + o1[1] * o1[1]) + (o1[2] * o1[2] + o1[3] * o1[3]);
#pragma unroll
            for (int o = 1; o < 16; o <<= 1) ss += __shfl_xor(ss, o);
            const float rs = rsqrtf(ss * (1.0f / 128.0f) + EPS);
            if (valid) {
                float z[8], y[8]; unpack8(zreg, z);
#pragma unroll
                for (int e = 0; e < 4; ++e) { y[e] = o0[e] * rs * gn[e] * siluf_(z[e]); y[4 + e] = o1[e] * rs * gn[4 + e] * siluf_(z[4 + e]); }
                *(u32x4*)(dummy ? (bf16_t*)(p.ws + OFF_HB) + rowof(b, t) * DM + h * 128 + cg8 : zp) = pack8(y);
            }
        }
    }
    __syncthreads();
}

__device__ __forceinline__ void hgrn_chain(const Params& p, int l, int b, int h, LAS unsigned char* lds, bool dummy = false) {
    const int tid = otid(), wave = tid >> 6, lane = tid & 63, r = lane & 15, q = lane >> 4;
    const int tok = tid >> 4, cg8 = (tid & 15) * 8;
    LAS bf16_t* sQ = (LAS bf16_t*)(lds + 0);
    LAS bf16_t* sKh = (LAS bf16_t*)(lds + 8704);
    LAS bf16_t* sV = (LAS bf16_t*)(lds + 17408);
    LAS bf16_t* sKt = (LAS bf16_t*)(lds + 27648);
    LAS bf16_t* sSc = (LAS bf16_t*)(lds + 37888);
    LAS bf16_t* sSt = (LAS bf16_t*)(lds + 40448);
    LAS float* sF = (LAS float*)(lds + 75264);
    LAS float* sO = (LAS float*)(lds + 91648);
    LAS float* sEbl = (LAS float*)(lds + 108544);
    bf16_t* proj = (bf16_t*)(p.ws + OFF_PROJ);
    for (int i = tid; i < 128 * 136 / 2; i += 512) ((LAS unsigned*)sSt)[i] = 0u;
    f32x4 Sacc[8];
#pragma unroll
    for (int i = 0; i < 8; ++i) Sacc[i] = (f32x4){0.f, 0.f, 0.f, 0.f};
    float gn[8], lbv[8];
#pragma unroll
    for (int e = 0; e < 8; ++e) {
        gn[e] = p.gnorm_b[l * 128 + cg8 + e];
        const float x0 = p.lbraw[h * 128 + cg8 + e], x1 = p.lbraw[512 + h * 128 + cg8 + e], mx = fmaxf(x0, x1);
        const float e0 = __expf(x0 - mx), e1 = __expf(x1 - mx), s0 = e0 / (e0 + e1), s1 = e1 / (e0 + e1);
        lbv[e] = (l == 0) ? 0.f : ((s0 + s1) - s0);
    }
    __syncthreads();
    const size_t rowbase = (size_t)b * TT;
    const int tr = wave >> 2, vc0 = (wave & 3) * 2;
    u32x4 pq, pf, pi, pz;
    { const bf16_t* rn = proj + rowof(b, tok) * NP + h * 128 + cg8; pq = *(const u32x4*)(rn + C_BQ); pf = *(const u32x4*)(rn + C_BF); pi = *(const u32x4*)(rn + C_BI); pz = *(const u32x4*)(rn + C_BG); }
    for (int c = 0; c < 65; ++c) {
        const int t0 = c * 32, t = t0 + tok; const bool valid = t < TT;
        float qv[8], kk[8], vv[8], lf[8];
        const u32x4 cq = pq, cf = pf, ci = pi, cz = pz;
        { const int tn = t + 32; if (tn < TT) { const bf16_t* rn = proj + rowof(b, tn) * NP + h * 128 + cg8;
            pq = *(const u32x4*)(rn + C_BQ); pf = *(const u32x4*)(rn + C_BF); pi = *(const u32x4*)(rn + C_BI); pz = *(const u32x4*)(rn + C_BG); } }
        if (valid) {
            float zq[8], zf[8]; unpack8(cq, zq); unpack8(cf, zf); unpack8(ci, vv);
#pragma unroll
            for (int e = 0; e < 8; ++e) {
                qv[e] = siluf_(zq[e]) * 0.08838834764831845f;
                const float z = zf[e];
                const float en = __expf(-fabsf(z));
                const float rden = __builtin_amdgcn_rcpf(1.0f + en);
                const float logsig = fminf(z, 0.f) - __logf(1.0f + en);
                const float sig = (z >= 0.f ? 1.0f : en) * rden;
                const float nsig = (z >= 0.f ? en : 1.0f) * rden;
                const float lb = lbv[e];
                if (lb > 0.f) { lf[e] = __logf(lb + (1.0f - lb) * sig); kk[e] = (1.0f - lb) * nsig; }
                else { lf[e] = logsig; kk[e] = nsig; }
            }
        } else {
#pragma unroll
            for (int e = 0; e < 8; ++e) { qv[e] = 0.f; kk[e] = 0.f; vv[e] = 0.f; lf[e] = 0.f; }
        }
        *(LAS f32x4*)(sF + tok * 128 + cg8) = (f32x4){lf[0], lf[1], lf[2], lf[3]};
        *(LAS f32x4*)(sF + tok * 128 + cg8 + 4) = (f32x4){lf[4], lf[5], lf[6], lf[7]};
        BAR_LDS();
        if (tid < 128) { float cs[32];
#pragma unroll
            for (int i = 0; i < 32; ++i) cs[i] = sF[i * 128 + tid];
#pragma unroll
            for (int i = 1; i < 32; ++i) cs[i] += cs[i - 1];
#pragma unroll
            for (int i = 0; i < 32; ++i) sF[i * 128 + tid] = cs[i];
            sEbl[tid] = __expf(cs[31]); }
        BAR_LDS();
        {
            const f32x4 b0 = *(const LAS f32x4*)(sF + tok * 128 + cg8), b1 = *(const LAS f32x4*)(sF + tok * 128 + cg8 + 4);
            const f32x4 l0 = *(const LAS f32x4*)(sEbl + cg8), l1 = *(const LAS f32x4*)(sEbl + cg8 + 4);
            float qt[8], kh[8], kt[8];
#pragma unroll
            for (int e = 0; e < 8; ++e) {
                const float bc = e < 4 ? b0[e & 3] : b1[e & 3], ebl = e < 4 ? l0[e & 3] : l1[e & 3];
                const float ebc = __expf(bc);
                qt[e] = qv[e] * ebc; kh[e] = kk[e] * __builtin_amdgcn_rcpf(ebc);
                kt[e] = kh[e] * ebl;
            }
            *(LAS u32x4*)(sKt + tok * 136 + cg8) = pack8(kt);
            *(LAS u32x4*)(sV + tok * 136 + cg8) = pack8(vv);
            *(LAS u32x4*)(sQ + tok * 136 + cg8) = pack8(qt);
            *(LAS u32x4*)(sKh + tok * 136 + cg8) = pack8(kh);
        }
        BAR_LDS();
        if (wave < 4) {
            const int ti = wave >> 1, tj = wave & 1;
            const f32x4 a = mma_tile<128>((f32x4){0.f, 0.f, 0.f, 0.f}, sQ + ti * 16 * 136, 136, sKh + tj * 16 * 136, 136, r, q);
            const int jcol = tj * 16 + r;
#pragma unroll
            for (int j = 0; j < 4; ++j) { const int i = ti * 16 + q * 4 + j; sSc[i * 40 + jcol] = f2bf((i >= jcol) ? a[j] : 0.f); }
        }
        f32x4 ao[2];
        {
            bf16x8 aQ[4];
#pragma unroll
            for (int kk = 0; kk < 4; ++kk) aQ[kk] = *(const LAS bf16x8*)(sQ + (tr * 16 + r) * 136 + kk * 32 + q * 8);
#pragma unroll
            for (int x = 0; x < 2; ++x) {
                ao[x] = (f32x4){0.f, 0.f, 0.f, 0.f};
#pragma unroll
                for (int kk = 0; kk < 4; ++kk) ao[x] = __builtin_amdgcn_mfma_f32_16x16x32_bf16(aQ[kk], *(const LAS bf16x8*)(sSt + ((vc0 + x) * 16 + r) * 136 + kk * 32 + q * 8), ao[x], 0, 0, 0);
            }
        }
        BAR_LDS();
        {
            const bf16x8 aSc = *(const LAS bf16x8*)(sSc + (tr * 16 + r) * 40 + q * 8);
#pragma unroll
            for (int x = 0; x < 2; ++x) {
                const int vc = vc0 + x;
                ao[x] = __builtin_amdgcn_mfma_f32_16x16x32_bf16(aSc, frag_tr(sV, 136, 0, vc * 16, lane), ao[x], 0, 0, 0);
#pragma unroll
                for (int j = 0; j < 4; ++j) sO[(tr * 16 + q * 4 + j) * 132 + vc * 16 + r] = ao[x][j];
            }
        }
        {
            const bf16x8 bV = frag_tr(sV, 136, 0, wave * 16, lane);
            bf16x8 aK[8];
#pragma unroll
            for (int kr = 0; kr < 8; ++kr) aK[kr] = frag_tr(sKt, 136, 0, kr * 16, lane);
#pragma unroll
            for (int kr = 0; kr < 8; ++kr) {
                const f32x4 ebl = *(const LAS f32x4*)(sEbl + kr * 16 + q * 4);
                Sacc[kr] = Sacc[kr] * ebl;
                Sacc[kr] = __builtin_amdgcn_mfma_f32_16x16x32_bf16(aK[kr], bV, Sacc[kr], 0, 0, 0);
                u32x2 w; w.x = cvt_pk_bf16(Sacc[kr][0], Sacc[kr][1]); w.y = cvt_pk_bf16(Sacc[kr][2], Sacc[kr][3]);
                *(LAS u32x2*)(sSt + (wave * 16 + r) * 136 + kr * 16 + q * 4) = w;
            }
        }
        BAR_LDS();
        {
            const f32x4 o0 = *(const LAS f32x4*)(sO + tok * 132 + cg8), o1 = *(const LAS f32x4*)(sO + tok * 132 + cg8 + 4);
            float ss = (o0[0] * o0[0] + o0[1] * o0[1]) + (o0[2] * o0[2] + o0[3] * o0[3]) + (o1[0] * o1[0] + o1[1] * o1[1]) + (o1[2] * o1[2] + o1[3] * o1[3]);
#pragma unroll
            for (int o = 1; o < 16; o <<= 1) ss += __shfl_xor(ss, o);
            const float rs = rsqrtf(ss * (1.0f / 128.0f) + EPS);
            if (valid) {
                bf16_t* zp = proj + rowof(b, t) * NP + C_BG + h * 128 + cg8;
                float z[8], y[8]; unpack8(cz, z);
#pragma unroll
                for (int e = 0; e < 4; ++e) { y[e] = o0[e] * rs * gn[e] * siluf_(z[e]); y[4 + e] = o1[e] * rs * gn[4 + e] * siluf_(z[4 + e]); }
                *(u32x4*)(dummy ? (bf16_t*)(p.ws + OFF_HB) + rowof(b, t) * DM + 512 + h * 128 + cg8 : zp) = pack8(y);
            }
        }
    }
    __syncthreads();
}

__device__ __forceinline__ void final_phase(const Params& p) {
    const int tid = otid(), wave = tid >> 6, lane = tid & 63;
    const int gw = blockIdx.x * 8 + wave, NGW = gridDim.x * 8;
    const float* sumsq = (const float*)(p.ws + OFF_SUMSQ) + (size_t)2 * MROWS;
    f32x4 w[4];
#pragma unroll
    for (int j = 0; j < 4; ++j) w[j] = *(const f32x4*)(p.fnw + 4 * lane + 256 * j);
    f32x4 vn[4]; float nss = 0.f;
    if (gw < NBATCH * SEQ) { nss = sumsq[gw];
#pragma unroll
        for (int j = 0; j < 4; ++j) vn[j] = *(const f32x4*)(p.out + (size_t)gw * DM + 4 * lane + 256 * j); }
    for (int rr = gw; rr < NBATCH * SEQ; rr += NGW) {
        f32x4 v[4]; const float css = nss;
#pragma unroll
        for (int j = 0; j < 4; ++j) v[j] = vn[j];
        if (rr + NGW < NBATCH * SEQ) { const size_t rn = (size_t)(rr + NGW); nss = sumsq[rn];
#pragma unroll
            for (int j = 0; j < 4; ++j) vn[j] = *(const f32x4*)(p.out + rn * DM + 4 * lane + 256 * j); }
        const float rs = rsqrtf(css * (1.0f / DM) + EPS);
        float* op = p.out + (size_t)rr * DM + 4 * lane;
#pragma unroll
        for (int j = 0; j < 4; ++j) *(f32x4*)(op + 256 * j) = v[j] * rs * w[j];
    }
}

template <int K>
__device__ __forceinline__ void run_phase(const Params& p, int l, LAS unsigned char* lds) {
    bf16_t* proj = (bf16_t*)(p.ws + OFF_PROJ); bf16_t* hb = (bf16_t*)(p.ws + OFF_HB);
    float* sumsq = (float*)(p.ws + OFF_SUMSQ);
    if constexpr (K == 0) phase0(p, lds);
    else if constexpr (K == 1) {
        bg_pass(p, l);
        pg8::Gemm g{hb, (const bf16_t*)(p.ws + OFF_W1T) + (size_t)l * NP * DM, MROWS, NP, DM, DM, DM};
        pg8::StaticOrder S; S.init(g.M, g.N, (int)gridDim.x, (int)blockIdx.x);
        pg8::EpiProj E{proj, sumsq + (size_t)l * MROWS};
        pg8::gemm_phase(lds, g, S, E);
    } else if constexpr (K == 6) {
        gdn_prep(p, l, lds);
    } else if constexpr (K == 2) {
        for (int ch = blockIdx.x; ch < 256; ch += gridDim.x) {
            if (ch < 128) gdn_chain(p, l, ch >> 2, ch & 3, lds);
            else hgrn_chain(p, l, (ch - 128) >> 2, ch & 3, lds);
        }
    } else if constexpr (K == 3) {
        const bf16_t* W23 = (const bf16_t*)(p.ws + OFF_W23T) + (size_t)l * DM * DM;
        const int Mrows = l == 1 ? NREAL : MROWS;
        pg8::StaticOrder S; S.init(Mrows, DM, (int)gridDim.x, (int)blockIdx.x);
        { pg8::Gemm g{proj + C_AZ, W23, Mrows, DM, 512, NP, DM}; pg8::EpiMix<0> E{proj}; pg8::gemm_phase(lds, g, S, E); }
        __builtin_amdgcn_fence(__ATOMIC_SEQ_CST, "agent");
        { pg8::Gemm g{proj + C_BG, W23 + 512, Mrows, DM, 512, NP, DM}; pg8::EpiMix<1> E{proj}; pg8::gemm_phase(lds, g, S, E); }
    } else if constexpr (K == 4) {
        pg8::Gemm g{proj, (const bf16_t*)(p.ws + OFF_W4T) + (size_t)l * DM * DM, l == 1 ? NREAL : MROWS, DM, DM, NP, DM};
        pg8::StaticOrder S; S.init(g.M, g.N, (int)gridDim.x, (int)blockIdx.x);
        pg8::EpiOut E{l, p.x, p.meta, p.out, (float*)(p.ws + OFF_HMETA), hb, sumsq + (size_t)(l + 1) * MROWS};
        pg8::gemm_phase(lds, g, S, E);
    } else final_phase(p);
}

#define XB_TMO      128
#define XB_XCNT(j)  (256  + 64 * (j))
#define XB_XSUB(j)  (1280 + 64 * (j))
#define XB_XGEN(j)  (2304 + 64 * (j))
#define XB_TOP      3328
#define XB_TOPGEN   3392
#define XCD_BAR_WORDS 3456
#define XB_SPIN_CAP (1u << 18)
__device__ __forceinline__ unsigned xb_ld(unsigned* p)              { return __hip_atomic_load(p, __ATOMIC_RELAXED, __HIP_MEMORY_SCOPE_AGENT); }
__device__ __forceinline__ unsigned xb_add(unsigned* p, unsigned v) { return __hip_atomic_fetch_add(p, v, __ATOMIC_RELAXED, __HIP_MEMORY_SCOPE_AGENT); }
__device__ __forceinline__ unsigned xb_xcc_id() { return (unsigned)__builtin_amdgcn_s_getreg((3 << 11) | 20) & 0xFu; }
#define XB_SPIN(cond, bar) do { unsigned _sp = 0; while (cond) { __builtin_amdgcn_s_sleep(1); \
    if ((++_sp & 255u) == 0u) { if (xb_ld(&(bar)[XB_TMO])) break; if (_sp > XB_SPIN_CAP) { atomicAdd(&(bar)[XB_TMO], 1u); break; } } } } while (0)
struct XcdBarrier { unsigned* bar; unsigned x; volatile LAS unsigned* st; };
__device__ __forceinline__ XcdBarrier xcd_barrier_post(unsigned* bar, volatile LAS unsigned* st) {
    XcdBarrier b; b.bar = bar; b.x = xb_xcc_id(); b.st = st;
    if (threadIdx.x == 0) (void)xb_add(&bar[XB_XCNT(b.x)], 1u);
    return b;
}
__device__ __forceinline__ void xcd_barrier_complete(unsigned* bar, unsigned x, unsigned& nloc, unsigned& nx) {
    const unsigned G = gridDim.x * gridDim.y * gridDim.z;
    unsigned sum, cnt, mine, sp = 0u;
    for (;;) {
        sum = 0u; cnt = 0u; mine = 0u;
#pragma unroll
        for (unsigned j = 0; j < 16; ++j) { const unsigned c = xb_ld(&bar[XB_XCNT(j)]); sum += c; cnt += (c > 0u) ? 1u : 0u; mine = (j == x) ? c : mine; }
        if (sum == G) break;
        __builtin_amdgcn_s_sleep(1);
        if ((++sp & 255u) == 0u) { if (xb_ld(&bar[XB_TMO])) break; if (sp > XB_SPIN_CAP) { atomicAdd(&bar[XB_TMO], 1u); break; } }
    }
    nloc = mine > 0u ? mine : 1u; nx = cnt > 0u ? cnt : 1u;
}
__device__ __forceinline__ void xcd_barrier(const XcdBarrier& b) {
    asm volatile("s_waitcnt vmcnt(0)" ::: "memory");
    __syncthreads();
    if (threadIdx.x == 0) {
        unsigned* bar = b.bar;
        __builtin_amdgcn_s_waitcnt(0);
        unsigned nloc = b.st[0], nx = b.st[1];
        if (nloc == 0u) { xcd_barrier_complete(bar, b.x, nloc, nx); b.st[0] = nloc; b.st[1] = nx; }
        const unsigned old = xb_add(&bar[XB_XSUB(b.x)], 1u);
        const unsigned gen = old / nloc;
        if (old + 1u == (gen + 1u) * nloc) {
            __builtin_amdgcn_fence(__ATOMIC_RELEASE, "agent");
            asm volatile("s_waitcnt vmcnt(0)" ::: "memory");
            const unsigned og = xb_add(&bar[XB_TOP], 1u);
            const unsigned tg = og / nx;
            if (og + 1u == (tg + 1u) * nx) xb_add(&bar[XB_TOPGEN], 1u);
            else XB_SPIN(xb_ld(&bar[XB_TOPGEN]) == tg, bar);
            __builtin_amdgcn_fence(__ATOMIC_ACQUIRE, "agent");
            xb_add(&bar[XB_XGEN(b.x)], 1u);
            asm volatile("s_waitcnt vmcnt(0)" ::: "memory");
        } else {
            XB_SPIN(xb_ld(&bar[XB_XGEN(b.x)]) == gen, bar);
            __builtin_amdgcn_fence(__ATOMIC_ACQUIRE, "agent");
            asm volatile("s_waitcnt vmcnt(0)" ::: "memory");
        }
    }
    __syncthreads();
}

#if MEGA
__global__ void __launch_bounds__(512, 2) fwd_kernel(Params p) {
    extern __shared__ __attribute__((aligned(16))) unsigned char smem[];
    LAS unsigned char* lds = (LAS unsigned char*)smem;
    cg::grid_group grid = cg::this_grid();
    volatile LAS unsigned* xst = (volatile LAS unsigned*)(lds + LDS_BYTES - 16);
    if (threadIdx.x < 4) xst[threadIdx.x] = 0u;
    __syncthreads();
    const XcdBarrier xb = xcd_barrier_post((unsigned*)(p.ws + OFF_XBAR), xst);
    run_phase<0>(p, 0, lds); grid.sync();
#pragma unroll 1
    for (int l = 0; l < 2; ++l) {
        run_phase<1>(p, l, lds); xcd_barrier(xb);
        run_phase<6>(p, l, lds); xcd_barrier(xb);
        run_phase<2>(p, l, lds); xcd_barrier(xb);
        run_phase<3>(p, l, lds); xcd_barrier(xb);
        run_phase<4>(p, l, lds); xcd_barrier(xb);
    }
    run_phase<5>(p, 0, lds);
}
#else
template <int K>
__global__ void __launch_bounds__(512, 2) k_phase(Params p, int l) {
    extern __shared__ __attribute__((aligned(16))) unsigned char smem[];
    run_phase<K>(p, l, (LAS unsigned char*)smem);
}
#endif

template <int K> static void launch_phase(const Params& p, int l, int grid, hipStream_t stream) {
#if !MEGA
    static bool attr = false;
    if (!attr) { if (hipFuncSetAttribute((const void*)k_phase<K>, hipFuncAttributeMaxDynamicSharedMemorySize, LDS_BYTES) != hipSuccess) fprintf(stderr, "hipFuncSetAttribute failed (phase %d)\n", K); attr = true; }
    hipLaunchKernelGGL((k_phase<K>), dim3(grid), dim3(512), LDS_BYTES, stream, p, l);
#endif
}

extern "C" void kernel_launch(void* const* d_in, const int* in_sizes, int n_in, void* d_out, int out_size, void* d_ws, size_t ws_size, hipStream_t stream) {
    static int grid = 0;
    if (grid == 0) {
        if (n_in != 14 || ws_size < WS_END) { fprintf(stderr, "kernel_launch: unexpected n_in %d / ws %zu (need %zu)\n", n_in, ws_size, (size_t)WS_END); grid = -1; return; }
        int dev = 0, cus = 0;
        (void)hipGetDevice(&dev);
        (void)hipDeviceGetAttribute(&cus, hipDeviceAttributeMultiprocessorCount, dev);
#if MEGA
        int per_cu = 0;
        if (hipFuncSetAttribute((const void*)fwd_kernel, hipFuncAttributeMaxDynamicSharedMemorySize, LDS_BYTES) != hipSuccess) fprintf(stderr, "kernel_launch: hipFuncSetAttribute failed\n");
        if (hipOccupancyMaxActiveBlocksPerMultiprocessor(&per_cu, (const void*)fwd_kernel, 512, LDS_BYTES) != hipSuccess || per_cu < 1) fprintf(stderr, "kernel_launch: occupancy query says %d\n", per_cu);
        (void)hipGetLastError();
#endif
        grid = cus;
        if (grid > 256 || grid < 1) grid = 256;
    }
    if (grid < 0) return;
    Params p{};
    p.x = (const float*)d_in[0]; p.meta = (const float*)d_in[1]; p.norm_w = (const float*)d_in[2]; p.w_in = (const float*)d_in[3]; p.conv_w = (const float*)d_in[4];
    p.a_log = (const float*)d_in[5]; p.dt_bias = (const float*)d_in[6]; p.gnorm_a = (const float*)d_in[7]; p.gnorm_b = (const float*)d_in[8]; p.lbraw = (const float*)d_in[9];
    p.wba = (const float*)d_in[10]; p.wbb = (const float*)d_in[11]; p.wout = (const float*)d_in[12]; p.fnw = (const float*)d_in[13];
    p.out = (float*)d_out; p.ws = (unsigned char*)d_ws;
#if MEGA
    (void)hipMemsetAsync((unsigned char*)d_ws + OFF_XBAR, 0, 16384, stream);
    void* args[] = {&p};
    hipError_t e = hipLaunchCooperativeKernel((const void*)fwd_kernel, dim3(grid), dim3(512), args, LDS_BYTES, stream);
    if (e != hipSuccess) fprintf(stderr, "cooperative launch failed: %s (grid %d)\n", hipGetErrorString(e), grid);
#else
    launch_phase<0>(p, 0, grid, stream);
    for (int l = 0; l < 2; ++l) { launch_phase<1>(p, l, grid, stream); launch_phase<6>(p, l, grid, stream); launch_phase<2>(p, l, grid, stream); launch_phase<3>(p, l, grid, stream); launch_phase<4>(p, l, grid, stream); }
    launch_phase<5>(p, 0, grid, stream);
#endif
}
```

```cpp
#include <hip/hip_runtime.h>
#include <hip/hip_cooperative_groups.h>
#include <cstdio>
namespace cg = cooperative_groups;

#ifndef PROBE_SCAN
#define PROBE_SCAN 0
#endif
#ifndef PROBE_G1
#define PROBE_G1 0
#endif
#ifndef MEGA
#define MEGA 1
#endif

#define LAS __attribute__((address_space(3)))
typedef unsigned short bf16_t;
typedef short bf16x8 __attribute__((ext_vector_type(8)));
typedef float f32x4 __attribute__((ext_vector_type(4)));
typedef unsigned u32x4 __attribute__((ext_vector_type(4)));
typedef unsigned u32x2 __attribute__((ext_vector_type(2)));

constexpr int DM = 1024, NBATCH = 32, SEQ = 2048, NMETA = 16, TT = SEQ + NMETA, MROWS = NBATCH * TT, NP = 6144, WIN = 6152;
constexpr float EPS = 1e-6f;
constexpr int NREAL = NBATCH * SEQ;
constexpr int C_AQ = 0, C_AK = 512, C_AV = 1024, C_BQ = 1536, C_BF = 2048, C_BI = 2560, C_AZ = 3072, C_BG = 3584, C_GA = 4096, C_GB = 5120;
constexpr size_t OFF_PROJ = 0;
constexpr size_t OFF_HB = OFF_PROJ + (size_t)MROWS * NP * 2;
constexpr size_t OFF_W1T = OFF_HB + (size_t)MROWS * DM * 2;
constexpr size_t OFF_W23T = OFF_W1T + (size_t)2 * NP * DM * 2;
constexpr size_t OFF_W4T = OFF_W23T + (size_t)2 * DM * DM * 2;
constexpr size_t OFF_W8 = OFF_W4T + (size_t)2 * DM * DM * 2;
constexpr size_t OFF_SUMSQ = OFF_W8 + (size_t)2 * 8 * DM * 4;
constexpr size_t OFF_BG = OFF_SUMSQ + (size_t)3 * MROWS * 4;
constexpr size_t OFF_HMETA = OFF_BG + (size_t)MROWS * 8 * 4;
constexpr size_t OFF_VB = OFF_HMETA + (size_t)NBATCH * NMETA * DM * 4;
constexpr size_t OFF_XBAR = OFF_VB + (size_t)MROWS * 512 * 2;
constexpr size_t WS_END = OFF_XBAR + 16384;
constexpr int LDS_BYTES = 133120;

struct Params {
    const float *x, *meta, *norm_w, *w_in, *conv_w, *a_log, *dt_bias, *gnorm_a, *gnorm_b, *lbraw, *wba, *wbb, *wout, *fnw;
    float* out;
    unsigned char* ws;
};

typedef __bf16 bf16x2_t __attribute__((ext_vector_type(2)));
__device__ __forceinline__ unsigned cvt_pk_bf16(float lo, float hi) { bf16x2_t v; v[0] = (__bf16)lo; v[1] = (__bf16)hi; return __builtin_bit_cast(unsigned, v); }
__device__ __forceinline__ bf16_t f2bf(float f) { return (bf16_t)(cvt_pk_bf16(f, 0.f) & 0xffffu); }
__device__ __forceinline__ float bflo(unsigned w) { return __uint_as_float(w << 16); }
__device__ __forceinline__ float bfhi(unsigned w) { return __uint_as_float(w & 0xffff0000u); }
__device__ __forceinline__ void unpack8(const u32x4 w, float (&o)[8]) {
    o[0] = bflo(w.x); o[1] = bfhi(w.x); o[2] = bflo(w.y); o[3] = bfhi(w.y); o[4] = bflo(w.z); o[5] = bfhi(w.z); o[6] = bflo(w.w); o[7] = bfhi(w.w);
}
__device__ __forceinline__ u32x4 pack8(const float (&v)[8]) {
    u32x4 w; w.x = cvt_pk_bf16(v[0], v[1]); w.y = cvt_pk_bf16(v[2], v[3]); w.z = cvt_pk_bf16(v[4], v[5]); w.w = cvt_pk_bf16(v[6], v[7]); return w;
}
__device__ __forceinline__ float sigmoidf_(float x) { return __builtin_amdgcn_rcpf(1.0f + __expf(-x)); }
__device__ __forceinline__ float siluf_(float x) { return x * __builtin_amdgcn_rcpf(1.0f + __expf(-x)); }
__device__ __forceinline__ float softplusf_(float x) { return fmaxf(x, 0.f) + log1pf(__expf(-fabsf(x))); }
__device__ __forceinline__ float wave_sum(float v) {
#pragma unroll
    for (int o = 1; o < 64; o <<= 1) v += __shfl_xor(v, o);
    return v;
}
__device__ __forceinline__ size_t rowof(int b, int t) { return t < NMETA ? (size_t)(NREAL + b * NMETA + t) : (size_t)b * SEQ + (size_t)(t - NMETA); }
#define LDS_WAIT() asm volatile("s_waitcnt lgkmcnt(0)" ::: "memory")
#define BAR_LDS() do { asm volatile("s_waitcnt lgkmcnt(0)" ::: "memory"); __builtin_amdgcn_s_barrier(); asm volatile("" ::: "memory"); } while (0)
__device__ __forceinline__ int otid() { int t = threadIdx.x; asm volatile("" : "+v"(t)); return t; }
__device__ __forceinline__ int obid() { int t = blockIdx.x; asm volatile("" : "+s"(t)); return t; }
__device__ __forceinline__ int ogrid() { int t = gridDim.x; asm volatile("" : "+s"(t)); return t; }

template <int KT>
__device__ __forceinline__ f32x4 mma_tile(f32x4 acc, const LAS bf16_t* A, int lda, const LAS bf16_t* B, int ldb, int r, int q) {
#pragma unroll
    for (int kk = 0; kk < KT; kk += 32) {
        const bf16x8 a = *(const LAS bf16x8*)(A + r * lda + kk + q * 8);
        const bf16x8 b = *(const LAS bf16x8*)(B + r * ldb + kk + q * 8);
        acc = __builtin_amdgcn_mfma_f32_16x16x32_bf16(a, b, acc, 0, 0, 0);
    }
    return acc;
}

typedef short s16x4 __attribute__((ext_vector_type(4)));
__device__ __forceinline__ bf16x8 frag_tr(const LAS bf16_t* T, int ld, int kbase, int cbase, int lane) {
    const int g = lane >> 4, qq = (lane & 15) >> 2, pp = lane & 3;
    const LAS bf16_t* p0 = T + (kbase + 8 * g + qq) * ld + cbase + 4 * pp;
    const s16x4 a = __builtin_amdgcn_ds_read_tr16_b64_v4i16((LAS s16x4*)p0);
    const s16x4 b = __builtin_amdgcn_ds_read_tr16_b64_v4i16((LAS s16x4*)(p0 + 4 * ld));
    return (bf16x8){a[0], a[1], a[2], a[3], b[0], b[1], b[2], b[3]};
}
template <int KT>
__device__ __forceinline__ f32x4 mma_tile_trB(f32x4 acc, const LAS bf16_t* A, int lda, const LAS bf16_t* Tb, int ldb, int n0, int lane) {
    const int r = lane & 15, q = lane >> 4;
#pragma unroll
    for (int kk = 0; kk < KT; kk += 32) {
        const bf16x8 a = *(const LAS bf16x8*)(A + r * lda + kk + q * 8);
        const bf16x8 b = frag_tr(Tb, ldb, kk, n0, lane);
        acc = __builtin_amdgcn_mfma_f32_16x16x32_bf16(a, b, acc, 0, 0, 0);
    }
    return acc;
}
template <int KT>
__device__ __forceinline__ f32x4 mma_tile_trA(f32x4 acc, const LAS bf16_t* Ta, int lda, int m0, const LAS bf16_t* B, int ldb, int lane) {
    const int r = lane & 15, q = lane >> 4;
#pragma unroll
    for (int kk = 0; kk < KT; kk += 32) {
        const bf16x8 a = frag_tr(Ta, lda, kk, m0, lane);
        const bf16x8 b = *(const LAS bf16x8*)(B + r * ldb + kk + q * 8);
        acc = __builtin_amdgcn_mfma_f32_16x16x32_bf16(a, b, acc, 0, 0, 0);
    }
    return acc;
}
template <int KT>
__device__ __forceinline__ f32x4 mma_tile_trAB(f32x4 acc, const LAS bf16_t* Ta, int lda, int m0, const LAS bf16_t* Tb, int ldb, int n0, int lane) {
#pragma unroll
    for (int kk = 0; kk < KT; kk += 32) {
        const bf16x8 a = frag_tr(Ta, lda, kk, m0, lane);
        const bf16x8 b = frag_tr(Tb, ldb, kk, n0, lane);
        acc = __builtin_amdgcn_mfma_f32_16x16x32_bf16(a, b, acc, 0, 0, 0);
    }
    return acc;
}

namespace pg8 {
constexpr int BM = 256, BK = 64, HALF = 128, HTB = HALF * BK * 2, NXCD = 8, WGM = 8;
__device__ __forceinline__ int lds_byte(int r, int c) { const int st = (r >> 4) * 2 + (c >> 5), rr = r & 15, cc = c & 31, ob = rr * 64 + cc * 2; return st * 1024 + (ob ^ (((ob >> 9) & 1) << 5)); }
__device__ __forceinline__ void stage_rc(int b, int& R, int& C) { const int st = b / 1024, sb = b % 1024, swz = sb ^ (((sb >> 9) & 1) << 5); R = (st >> 1) * 16 + swz / 64; C = (st & 1) * 32 + (swz % 64) / 2; }
__device__ __forceinline__ int perm32(int rho) { const int n = rho >> 4, i = rho & 15; return 8 * (i >> 2) + 4 * n + (i & 3); }
struct Unit { int pm, pn; };
struct Gemm { const bf16_t* A; const bf16_t* Bt; int M, N, K, lda, ldb; };
struct StaticOrder {
    int nM, nN, nwg, G, c;
    __device__ void init(int M, int N, int G_, int c_) { nM = M / BM; nN = N / BM; nwg = nM * nN; G = G_; c = c_; }
    __device__ bool next(int i, Unit& u) const {
        const long L = (long)i * G + c; if (L >= nwg) return false;
        int wgid = (int)L; { const int q = nwg / NXCD, r = nwg % NXCD, xcd = wgid % NXCD, off = wgid / NXCD; wgid = (xcd < r ? xcd * (q + 1) : r * (q + 1) + (xcd - r) * q) + off; }
        const int nig = WGM * nN, gid = wgid / nig, fm = gid * WGM, gsz = (nM - fm) < WGM ? (nM - fm) : WGM;
        u.pm = fm + ((wgid % nig) % gsz); u.pn = (wgid % nig) / gsz; return true;
    }
};

template <class Epi>
__device__ __forceinline__ void gemm_phase(LAS unsigned char* lds, const Gemm g, const StaticOrder& S, const Epi& E) {
    const int tid = otid(), wid = __builtin_amdgcn_readfirstlane(tid >> 6), lane = tid & 63, wr = wid >> 2, wc = wid & 3, fr = lane & 15, fq = lane >> 4;
    const int K = g.K, nt = K / BK;
    unsigned voffA[2], voffB[2];
#pragma unroll
    for (int i = 0; i < 2; ++i) { int R, C; stage_rc(tid * 16 + i * 8192, R, C); const int Rb = (R & ~31) + perm32(R & 31);
        voffA[i] = (unsigned)(R * g.lda + C) * 2u; voffB[i] = (unsigned)(Rb * g.ldb + C) * 2u; }
    const size_t kstep = (size_t)(BK * 2);
    const size_t hstepA = (size_t)HALF * g.lda * 2, hstepB = (size_t)HALF * g.ldb * 2;
    const size_t tstepA = 2 * hstepA, tstepB = 2 * hstepB;
    const unsigned ldsw = (unsigned)wid * 1024u;
    const int aoff = lds_byte(wr * 64 + fr, fq * 8), boff = lds_byte(wc * 32 + fr, fq * 8);
#define PG8_SA(b, h) (((b) * 2 + (h)) * HTB)
#define PG8_SB(b, h) ((4 + (b) * 2 + (h)) * HTB)
#define PG8_STAGE(bufoff, gbase, voff) do { _Pragma("unroll") for (int _i = 0; _i < 2; ++_i) \
        __builtin_amdgcn_global_load_lds((const unsigned*)((const char*)(gbase) + (voff)[_i]), (LAS unsigned*)(lds + (bufoff) + ldsw + _i * 8192), 16, 0, 0); } while (0)
#define PG8_LDA(dst, b, h) do { _Pragma("unroll") for (int m = 0; m < 4; ++m) _Pragma("unroll") for (int k = 0; k < 2; ++k) dst[m][k] = *(const LAS bf16x8*)(lds + PG8_SA(b, h) + aoff + m * 2048 + k * 1024); } while (0)
#define PG8_LDB(dst, b, h) do { _Pragma("unroll") for (int n = 0; n < 2; ++n) _Pragma("unroll") for (int k = 0; k < 2; ++k) dst[n][k] = *(const LAS bf16x8*)(lds + PG8_SB(b, h) + boff + n * 2048 + k * 1024); } while (0)
#define PG8_MMA(ai, bj, At, Bt) do { __builtin_amdgcn_s_setprio(1); _Pragma("unroll") for (int m = 0; m < 4; ++m) _Pragma("unroll") for (int n = 0; n < 2; ++n) _Pragma("unroll") for (int k = 0; k < 2; ++k) \
        acc[ai][bj][m][n] = __builtin_amdgcn_mfma_f32_16x16x32_bf16(Bt[n][k], At[m][k], acc[ai][bj][m][n], 0, 0, 0); __builtin_amdgcn_s_setprio(0); } while (0)
#define PG8_WAIT_V(n) asm volatile("s_waitcnt vmcnt(" #n ")" ::: "memory")
#define PG8_WAIT_L(n) asm volatile("s_waitcnt lgkmcnt(" #n ")" ::: "memory")
#define PG8_BAR __builtin_amdgcn_s_barrier()
#define PG8_SCHED __builtin_amdgcn_sched_barrier(0)
    Unit cur, nxt; int ui = 0;
    if (!S.next(0, cur)) return;
    f32x4 acc[2][2][4][2];
#pragma unroll
    for (int a = 0; a < 2; ++a)
#pragma unroll
        for (int b = 0; b < 2; ++b)
#pragma unroll
            for (int m = 0; m < 4; ++m)
#pragma unroll
                for (int n = 0; n < 2; ++n) acc[a][b][m][n] = (f32x4){0.f, 0.f, 0.f, 0.f};
    bf16x8 At[4][2], B0[2][2], B1[2][2];
    const char* cA = (const char*)g.A + (size_t)cur.pm * tstepA; const char* cB = (const char*)g.Bt + (size_t)cur.pn * tstepB;
    PG8_STAGE(PG8_SB(0, 0), cB, voffB); PG8_STAGE(PG8_SA(0, 0), cA, voffA); PG8_STAGE(PG8_SB(0, 1), cB + hstepB, voffB); PG8_STAGE(PG8_SA(0, 1), cA + hstepA, voffA);
    if (wr == 1) PG8_BAR;
    PG8_WAIT_V(4); PG8_BAR;
    PG8_STAGE(PG8_SB(1, 0), cB + kstep, voffB); PG8_STAGE(PG8_SA(1, 0), cA + kstep, voffA); PG8_STAGE(PG8_SB(1, 1), cB + hstepB + kstep, voffB);
    PG8_WAIT_V(6); PG8_BAR;
    for (;;) {
        const bool has_next = S.next(ui + 1, nxt);
        const char* nA = has_next ? (const char*)g.A + (size_t)nxt.pm * tstepA : cA; const char* nB = has_next ? (const char*)g.Bt + (size_t)nxt.pn * tstepB : cB;
        for (int t = 0; t < nt; t += 2) {
            const bool last = (t == nt - 2);
            const char* a1 = cA + (size_t)(t + 1) * kstep;
            const char* a2 = last ? nA : cA + (size_t)(t + 2) * kstep; const char* b2 = last ? nB : cB + (size_t)(t + 2) * kstep;
            const char* a3 = a2 + kstep; const char* b3 = b2 + kstep;
            PG8_LDB(B0, 0, 0); PG8_SCHED; PG8_LDA(At, 0, 0); PG8_STAGE(PG8_SA(1, 1), a1 + hstepA, voffA);
            PG8_WAIT_L(8); PG8_BAR; PG8_WAIT_L(0); PG8_MMA(0, 0, At, B0); PG8_BAR; PG8_SCHED;
            PG8_LDB(B1, 0, 1); PG8_STAGE(PG8_SB(0, 0), b2, voffB);
            PG8_BAR; PG8_WAIT_L(0); PG8_MMA(0, 1, At, B1); PG8_BAR;
            PG8_LDA(At, 0, 1); PG8_STAGE(PG8_SA(0, 0), a2, voffA);
            PG8_BAR; PG8_WAIT_L(0); PG8_MMA(1, 0, At, B0); PG8_BAR; PG8_SCHED;
            PG8_STAGE(PG8_SB(0, 1), b2 + hstepB, voffB);
            PG8_WAIT_V(6); PG8_BAR; PG8_MMA(1, 1, At, B1); PG8_BAR;
            PG8_LDB(B0, 1, 0); PG8_SCHED; PG8_LDA(At, 1, 0); PG8_STAGE(PG8_SA(0, 1), a2 + hstepA, voffA);
            PG8_WAIT_L(8); PG8_BAR; PG8_WAIT_L(0); PG8_MMA(0, 0, At, B0); PG8_BAR; PG8_SCHED;
            PG8_LDB(B1, 1, 1); PG8_STAGE(PG8_SB(1, 0), b3, voffB);
            PG8_BAR; PG8_WAIT_L(0); PG8_MMA(0, 1, At, B1); PG8_BAR;
            PG8_LDA(At, 1, 1); PG8_STAGE(PG8_SA(1, 0), a3, voffA);
            PG8_BAR; PG8_WAIT_L(0); PG8_MMA(1, 0, At, B0); PG8_BAR; PG8_SCHED;
            PG8_STAGE(PG8_SB(1, 1), b3 + hstepB, voffB);
            PG8_WAIT_V(6); PG8_BAR; PG8_MMA(1, 1, At, B1); PG8_BAR;
        }
        E(acc, cur, wr, wc, fr, fq);
        if (!has_next) break;
#pragma unroll
        for (int a = 0; a < 2; ++a)
#pragma unroll
            for (int b = 0; b < 2; ++b)
#pragma unroll
                for (int m = 0; m < 4; ++m)
#pragma unroll
                    for (int n = 0; n < 2; ++n) acc[a][b][m][n] = (f32x4){0.f, 0.f, 0.f, 0.f};
        cur = nxt; cA = nA; cB = nB; ++ui;
    }
    PG8_WAIT_V(0);
    if (wr == 0) PG8_BAR;
    PG8_BAR;
#undef PG8_SA
#undef PG8_SB
#undef PG8_STAGE
#undef PG8_LDA
#undef PG8_LDB
#undef PG8_MMA
#undef PG8_WAIT_V
#undef PG8_WAIT_L
#undef PG8_BAR
#undef PG8_SCHED
}

typedef f32x4 Acc[2][2][4][2];

struct EpiProj {
    static constexpr bool HAS_MID = false;
    bf16_t* O; const float* sumsq;
    __device__ __forceinline__ void operator()(const Acc& acc, const Unit& u, int wr, int wc, int fr, int fq) const {
        const int row0 = u.pm * BM + wr * 64 + fr, col0 = u.pn * BM + wc * 32 + 8 * fq;
        float ssq[2][4];
#pragma unroll
        for (int ai = 0; ai < 2; ++ai)
#pragma unroll
            for (int m = 0; m < 4; ++m) ssq[ai][m] = sumsq[row0 + ai * HALF + m * 16];
        __builtin_amdgcn_sched_barrier(0);
#pragma unroll
        for (int ai = 0; ai < 2; ++ai)
#pragma unroll
            for (int m = 0; m < 4; ++m) {
                const int row = row0 + ai * HALF + m * 16;
                const float rs = rsqrtf(ssq[ai][m] * (1.0f / DM) + EPS);
                bf16_t* rowp = O + (size_t)row * NP + col0;
#pragma unroll
                for (int bj = 0; bj < 2; ++bj) {
                    const f32x4 v0 = acc[ai][bj][m][0] * rs, v1 = acc[ai][bj][m][1] * rs;
                    u32x4 w; w.x = cvt_pk_bf16(v0[0], v0[1]); w.y = cvt_pk_bf16(v0[2], v0[3]); w.z = cvt_pk_bf16(v1[0], v1[1]); w.w = cvt_pk_bf16(v1[2], v1[3]);
                    __builtin_nontemporal_store(w, (u32x4*)(rowp + bj * HALF));
                }
            }
    }
};
#define EPI_SB() __builtin_amdgcn_sched_barrier(0)
template <int SECOND>
struct EpiMix {
    static constexpr bool HAS_MID = false;
    bf16_t* proj;
    template <int AIM> __device__ __forceinline__ void load_q(u32x4 (&wg)[2][2], u32x4 (&wp)[2][2], int row0, int col0) const {
        constexpr int ai = AIM >> 1, m0 = (AIM & 1) * 2;
#pragma unroll
        for (int mm = 0; mm < 2; ++mm) {
            const bf16_t* rowp = proj + (size_t)(row0 + ai * HALF + (m0 + mm) * 16) * NP + col0;
#pragma unroll
            for (int bj = 0; bj < 2; ++bj) {
                wg[mm][bj] = *(const u32x4*)(rowp + (SECOND ? C_GB : C_GA) + bj * HALF);
                if (SECOND) wp[mm][bj] = *(const u32x4*)(rowp + bj * HALF); else wp[mm][bj] = (u32x4){0u, 0u, 0u, 0u};
            }
        }
    }
    template <int AIM> __device__ __forceinline__ void proc_q(const Acc& acc, const u32x4 (&wg)[2][2], const u32x4 (&wp)[2][2], int row0, int col0) const {
        constexpr int ai = AIM >> 1, m0 = (AIM & 1) * 2;
#pragma unroll
        for (int mm = 0; mm < 2; ++mm) {
            bf16_t* rowp = proj + (size_t)(row0 + ai * HALF + (m0 + mm) * 16) * NP + col0;
#pragma unroll
            for (int bj = 0; bj < 2; ++bj) {
                float gt[8], o[8]; unpack8(wg[mm][bj], gt); unpack8(wp[mm][bj], o);
#pragma unroll
                for (int e = 0; e < 8; ++e) o[e] += acc[ai][bj][m0 + mm][e >> 2][e & 3] * sigmoidf_(gt[e]);
                *(u32x4*)(rowp + bj * HALF) = pack8(o);
            }
        }
    }
    __device__ __forceinline__ void operator()(const Acc& acc, const Unit& u, int wr, int wc, int fr, int fq) const {
        const int row0 = u.pm * BM + wr * 64 + fr, col0 = u.pn * BM + wc * 32 + 8 * fq;
        u32x4 g0[2][2], p0[2][2], g1[2][2], p1[2][2];
        load_q<0>(g0, p0, row0, col0); load_q<1>(g1, p1, row0, col0); EPI_SB();
        proc_q<0>(acc, g0, p0, row0, col0); EPI_SB(); load_q<2>(g0, p0, row0, col0); EPI_SB();
        proc_q<1>(acc, g1, p1, row0, col0); EPI_SB(); load_q<3>(g1, p1, row0, col0); EPI_SB();
        proc_q<2>(acc, g0, p0, row0, col0); EPI_SB();
        proc_q<3>(acc, g1, p1, row0, col0); EPI_SB();
    }
};
struct EpiOut {
    static constexpr bool HAS_MID = false;
    int layer; const float* x; const float* meta; float* out; float* hmeta; bf16_t* hb; float* sumsq_next;
    template <int AIM> __device__ __forceinline__ void load_r(f32x4 (&rr)[2][2], int row0, int col0) const {
        constexpr int ai = AIM >> 2, m = AIM & 3;
        const int row = row0 + ai * HALF + m * 16;
        const bool ism = row >= NREAL; const int idx = ism ? row - NREAL : 0;
        const float* rp;
        if (layer == 0) rp = ism ? meta + (size_t)(idx & (NMETA - 1)) * DM : x + (size_t)row * DM;
        else rp = ism ? hmeta + (size_t)idx * DM : out + (size_t)row * DM;
#pragma unroll
        for (int bj = 0; bj < 2; ++bj) { const int c = col0 + bj * HALF; rr[bj][0] = *(const f32x4*)(rp + c); rr[bj][1] = *(const f32x4*)(rp + c + 4); }
    }
    template <int AIM> __device__ __forceinline__ void proc_r(const Acc& acc, const f32x4 (&rr)[2][2], int row0, int col0, int fq) const {
        constexpr int ai = AIM >> 2, m = AIM & 3;
        const int row = row0 + ai * HALF + m * 16;
        const bool ism = row >= NREAL; const int idx = ism ? row - NREAL : 0;
        float* wp = ism ? hmeta + (size_t)idx * DM : out + (size_t)row * DM;
        const bool do_store = (layer == 0) || !ism;
        float ss = 0.f;
#pragma unroll
        for (int bj = 0; bj < 2; ++bj) {
            const int c = col0 + bj * HALF;
            const f32x4 v0 = acc[ai][bj][m][0] + rr[bj][0], v1 = acc[ai][bj][m][1] + rr[bj][1];
            if (do_store) { *(f32x4*)(wp + c) = v0; *(f32x4*)(wp + c + 4) = v1; }
            if (layer == 0) { u32x4 w; w.x = cvt_pk_bf16(v0[0], v0[1]); w.y = cvt_pk_bf16(v0[2], v0[3]); w.z = cvt_pk_bf16(v1[0], v1[1]); w.w = cvt_pk_bf16(v1[2], v1[3]);
                *(u32x4*)(hb + (size_t)row * DM + c) = w; }
            ss += (v0[0] * v0[0] + v0[1] * v0[1]) + (v0[2] * v0[2] + v0[3] * v0[3]) + (v1[0] * v1[0] + v1[1] * v1[1]) + (v1[2] * v1[2] + v1[3] * v1[3]);
        }
        ss += __shfl_xor(ss, 16); ss += __shfl_xor(ss, 32);
        if (fq == 0) atomicAdd(sumsq_next + row, ss);
    }
    __device__ __forceinline__ void operator()(const Acc& acc, const Unit& u, int wr, int wc, int fr, int fq) const {
        const int row0 = u.pm * BM + wr * 64 + fr, col0 = u.pn * BM + wc * 32 + 8 * fq;
        f32x4 r0[2][2], r1[2][2];
        load_r<0>(r0, row0, col0); load_r<1>(r1, row0, col0); EPI_SB();
        proc_r<0>(acc, r0, row0, col0, fq); EPI_SB(); load_r<2>(r0, row0, col0); EPI_SB();
        proc_r<1>(acc, r1, row0, col0, fq); EPI_SB(); load_r<3>(r1, row0, col0); EPI_SB();
        proc_r<2>(acc, r0, row0, col0, fq); EPI_SB(); load_r<4>(r0, row0, col0); EPI_SB();
        proc_r<3>(acc, r1, row0, col0, fq); EPI_SB(); load_r<5>(r1, row0, col0); EPI_SB();
        proc_r<4>(acc, r0, row0, col0, fq); EPI_SB(); load_r<6>(r0, row0, col0); EPI_SB();
        proc_r<5>(acc, r1, row0, col0, fq); EPI_SB(); load_r<7>(r1, row0, col0); EPI_SB();
        proc_r<6>(acc, r0, row0, col0, fq); EPI_SB();
        proc_r<7>(acc, r1, row0, col0, fq); EPI_SB();
    }
};
}

__device__ __forceinline__ void transpose_item(const float* W, int ldw, const float* scale, bf16_t* WT, int ldt, LAS float* scr, int lane) {
    float tv[32];
#pragma unroll
    for (int i = 0; i < 32; ++i) { const int kk = 2 * i + (lane >> 5); tv[i] = W[(size_t)kk * ldw + (lane & 31)]; }
#pragma unroll
    for (int i = 0; i < 32; ++i) { const int kk = 2 * i + (lane >> 5); scr[kk * 33 + (lane & 31)] = tv[i] * (scale ? scale[kk] : 1.0f); }
    LDS_WAIT();
    const int c = lane & 7;
#pragma unroll
    for (int j = 0; j < 4; ++j) { const int n = (lane >> 3) + 8 * j; const LAS float* s = scr + (8 * c) * 33 + n;
        u32x4 o; o.x = cvt_pk_bf16(s[0 * 33], s[1 * 33]); o.y = cvt_pk_bf16(s[2 * 33], s[3 * 33]); o.z = cvt_pk_bf16(s[4 * 33], s[5 * 33]); o.w = cvt_pk_bf16(s[6 * 33], s[7 * 33]);
        *(u32x4*)(WT + (size_t)n * ldt + 8 * c) = o; }
    LDS_WAIT();
}
__device__ __forceinline__ int orig_col(int n) { return n < 1536 ? n : (n < 3072 ? n + 520 : (n < 3584 ? n - 1528 : n + 8)); }

__device__ __forceinline__ void phase0(const Params& p, LAS unsigned char* lds) {
    const int tid = otid(), wave = tid >> 6, lane = tid & 63;
    const int gw = blockIdx.x * 8 + wave, NGW = gridDim.x * 8;
    LAS float* scr = (LAS float*)(lds + wave * 8448);
    bf16_t* W1T = (bf16_t*)(p.ws + OFF_W1T); bf16_t* W23T = (bf16_t*)(p.ws + OFF_W23T); bf16_t* W4T = (bf16_t*)(p.ws + OFF_W4T);
    for (int it = gw; it < 8192; it += NGW) {
        const int l = it >> 12; int r = it & 4095;
        if (r < 3072) { const int kb = r / 192, nb = r % 192, n0 = nb * 32, k0 = kb * 64;
            transpose_item(p.w_in + (size_t)l * DM * WIN + (size_t)k0 * WIN + orig_col(n0), WIN, p.norm_w + l * DM + k0, W1T + (size_t)l * NP * DM + (size_t)n0 * DM + k0, DM, scr, lane);
        } else if (r < 3584) { r -= 3072; const int kb = r / 32, nb = r % 32, n0 = nb * 32, k0 = kb * 64;
            const float* src = kb < 8 ? p.wba + (size_t)l * 512 * DM + (size_t)k0 * DM + n0 : p.wbb + (size_t)l * 512 * DM + (size_t)(k0 - 512) * DM + n0;
            transpose_item(src, DM, nullptr, W23T + (size_t)l * DM * DM + (size_t)n0 * DM + k0, DM, scr, lane);
        } else { r -= 3584; const int kb = r / 32, nb = r % 32, n0 = nb * 32, k0 = kb * 64;
            transpose_item(p.wout + (size_t)l * DM * DM + (size_t)k0 * DM + n0, DM, nullptr, W4T + (size_t)l * DM * DM + (size_t)n0 * DM + k0, DM, scr, lane);
        }
    }
    float* W8 = (float*)(p.ws + OFF_W8);
    for (int i = blockIdx.x * 512 + tid; i < 2 * 8 * DM; i += gridDim.x * 512) { const int l = i >> 13, j = (i >> 10) & 7, k = i & 1023;
        W8[i] = p.norm_w[l * DM + k] * p.w_in[(size_t)l * DM * WIN + (size_t)k * WIN + 1536 + j]; }
    bf16_t* hb = (bf16_t*)(p.ws + OFF_HB); float* sumsq = (float*)(p.ws + OFF_SUMSQ);
    auto row_src = [&](const int row) { return row < NREAL ? p.x + (size_t)row * DM : p.meta + (size_t)((row - NREAL) & (NMETA - 1)) * DM; };
    f32x4 vn[4];
    if (gw < MROWS) { const float* src = row_src(gw);
#pragma unroll
        for (int j = 0; j < 4; ++j) vn[j] = *(const f32x4*)(src + 4 * lane + 256 * j); }
    for (int row = gw; row < MROWS; row += NGW) {
        f32x4 v[4]; float s = 0.f;
#pragma unroll
        for (int j = 0; j < 4; ++j) v[j] = vn[j];
        if (row + NGW < MROWS) { const float* src = row_src(row + NGW);
#pragma unroll
            for (int j = 0; j < 4; ++j) vn[j] = *(const f32x4*)(src + 4 * lane + 256 * j); }
#pragma unroll
        for (int j = 0; j < 4; ++j) s += (v[j][0] * v[j][0] + v[j][1] * v[j][1]) + (v[j][2] * v[j][2] + v[j][3] * v[j][3]);
        s = wave_sum(s);
#pragma unroll
        for (int j = 0; j < 4; ++j) { u32x2 o; o.x = cvt_pk_bf16(v[j][0], v[j][1]); o.y = cvt_pk_bf16(v[j][2], v[j][3]); *(u32x2*)(hb + (size_t)row * DM + 4 * lane + 256 * j) = o; }
        if (lane == 0) { sumsq[row] = s; sumsq[MROWS + row] = 0.f; sumsq[2 * MROWS + row] = 0.f; }
    }
}

__device__ __forceinline__ void bg_pass(const Params& p, int l) {
    const int tid = otid(), wave = tid >> 6, lane = tid & 63;
    const int gw = blockIdx.x * 8 + wave, NGW = gridDim.x * 8;
    const float* W8 = (const float*)(p.ws + OFF_W8) + (size_t)l * 8 * DM;
    const bf16_t* hb = (const bf16_t*)(p.ws + OFF_HB); const float* sumsq = (const float*)(p.ws + OFF_SUMSQ) + (size_t)l * MROWS;
    float* bg = (float*)(p.ws + OFF_BG);
    float wr_[8][16];
#pragma unroll
    for (int j = 0; j < 8; ++j) {
        const f32x4 a0 = *(const f32x4*)(W8 + j * DM + 8 * lane), a1 = *(const f32x4*)(W8 + j * DM + 8 * lane + 4), b0 = *(const f32x4*)(W8 + j * DM + 512 + 8 * lane), b1 = *(const f32x4*)(W8 + j * DM + 512 + 8 * lane + 4);
#pragma unroll
        for (int e = 0; e < 4; ++e) { wr_[j][e] = a0[e]; wr_[j][4 + e] = a1[e]; wr_[j][8 + e] = b0[e]; wr_[j][12 + e] = b1[e]; }
    }
    const int jj = lane & 7, hh = jj & 3;
    const float alog = p.a_log[l * 4 + hh], dtb = p.dt_bias[l * 4 + hh];
    u32x4 n0 = (u32x4){0u, 0u, 0u, 0u}, n1 = n0; float nss = 0.f;
    if (gw < MROWS) { n0 = *(const u32x4*)(hb + (size_t)gw * DM + 8 * lane); n1 = *(const u32x4*)(hb + (size_t)gw * DM + 512 + 8 * lane); nss = sumsq[gw]; }
    for (int row = gw; row < MROWS; row += NGW) {
        const u32x4 w0 = n0, w1 = n1; const float css = nss;
        if (row + NGW < MROWS) { const size_t rn = (size_t)(row + NGW); n0 = *(const u32x4*)(hb + rn * DM + 8 * lane); n1 = *(const u32x4*)(hb + rn * DM + 512 + 8 * lane); nss = sumsq[rn]; }
        float hv[16]; { float t0[8], t1[8]; unpack8(w0, t0); unpack8(w1, t1);
#pragma unroll
            for (int e = 0; e < 8; ++e) { hv[e] = t0[e]; hv[8 + e] = t1[e]; } }
        float d[8];
#pragma unroll
        for (int j = 0; j < 8; ++j) { float s = 0.f;
#pragma unroll
            for (int e = 0; e < 16; ++e) s += hv[e] * wr_[j][e];
            d[j] = wave_sum(s); }
        const float rs = rsqrtf(css * (1.0f / DM) + EPS);
        float val = d[0];
#pragma unroll
        for (int j = 1; j < 8; ++j) val = (jj == j) ? d[j] : val;
        val *= rs;
        const float o = jj < 4 ? sigmoidf_(val) : -__expf(alog) * softplusf_(val + dtb);
        if (lane < 8) bg[(size_t)row * 8 + lane] = o;
    }
}

__device__ __forceinline__ void gdn_prep(const Params& p, int l, LAS unsigned char* lds) {
    const int tid = otid();
    const int tok = tid >> 4, cg8 = (tid & 15) * 8;
    LAS float* sCW = (LAS float*)lds;
    for (int i = tid; i < 4 * 3 * 4 * 128; i += 512) { const int h = i / 1536, rem = i - h * 1536, mat = rem >> 9, tap = (rem >> 7) & 3, c = rem & 127; sCW[i] = p.conv_w[(size_t)l * 4 * 1536 + tap * 1536 + mat * 512 + h * 128 + c]; }
    __syncthreads();
    const bf16_t* proj = (const bf16_t*)(p.ws + OFF_PROJ);
    bf16_t* qk = (bf16_t*)(p.ws + OFF_HB); bf16_t* vb = (bf16_t*)(p.ws + OFF_VB);
    constexpr int NIT = NBATCH * 65 * 4;
    const int G = ogrid();
    auto load_item = [&](const int it, u32x4 (&raw)[3][4]) {
        const int h = it & 3, bc = it >> 2, b = bc / 65, c = bc - b * 65;
        const int t = c * 32 + tok; const bool valid = t < TT;
#pragma unroll
        for (int mat = 0; mat < 3; ++mat)
#pragma unroll
            for (int tap = 0; tap < 4; ++tap) {
                const int ts = t - 3 + tap;
                raw[mat][tap] = (u32x4){0u, 0u, 0u, 0u};
                if (valid && ts >= 0) raw[mat][tap] = *(const u32x4*)(proj + rowof(b, ts) * NP + mat * 512 + h * 128 + cg8);
            }
    };
    auto compute_item = [&](const int it, const u32x4 (&rc)[3][4]) {
        const int h = it & 3, bc = it >> 2, b = bc / 65, c = bc - b * 65;
            const int t = c * 32 + tok; const bool valid = t < TT;
            float cv[3][8];
#pragma unroll
            for (int mat = 0; mat < 3; ++mat) {
#pragma unroll
                for (int e = 0; e < 8; ++e) cv[mat][e] = 0.f;
#pragma unroll
                for (int tap = 0; tap < 4; ++tap) {
                    float xr[8]; unpack8(rc[mat][tap], xr);
                    const f32x4 c0 = *(const LAS f32x4*)(sCW + h * 1536 + (mat * 4 + tap) * 128 + cg8), c1 = *(const LAS f32x4*)(sCW + h * 1536 + (mat * 4 + tap) * 128 + cg8 + 4);
#pragma unroll
                    for (int e = 0; e < 4; ++e) { cv[mat][e] += c0[e] * xr[e]; cv[mat][4 + e] += c1[e] * xr[4 + e]; }
                }
#pragma unroll
                for (int e = 0; e < 8; ++e) cv[mat][e] = siluf_(cv[mat][e]);
            }
            float sq = 0.f, sk = 0.f;
#pragma unroll
            for (int e = 0; e < 8; ++e) { sq += cv[0][e] * cv[0][e]; sk += cv[1][e] * cv[1][e]; }
#pragma unroll
            for (int o = 1; o < 16; o <<= 1) { sq += __shfl_xor(sq, o); sk += __shfl_xor(sk, o); }
            const float rq = rsqrtf(sq + EPS) * 0.08838834764831845f, rk = rsqrtf(sk + EPS);
#pragma unroll
            for (int e = 0; e < 8; ++e) { cv[0][e] *= rq; cv[1][e] *= rk; }
            if (valid) {
                const size_t row = rowof(b, t);
                *(u32x4*)(qk + row * DM + h * 128 + cg8) = pack8(cv[0]);
                *(u32x4*)(qk + row * DM + 512 + h * 128 + cg8) = pack8(cv[1]);
                *(u32x4*)(vb + row * 512 + h * 128 + cg8) = pack8(cv[2]);
            }
    };
    u32x4 r0[3][4], r1[3][4], r2[3][4];
    int it = obid();
    if (it < NIT) load_item(it, r0);
    if (it + G < NIT) load_item(it + G, r1);
    while (it < NIT) {
        if (it + 2 * G < NIT) load_item(it + 2 * G, r2);
        compute_item(it, r0); it += G; if (it >= NIT) break;
        if (it + 2 * G < NIT) load_item(it + 2 * G, r0);
        compute_item(it, r1); it += G; if (it >= NIT) break;
        if (it + 2 * G < NIT) load_item(it + 2 * G, r1);
        compute_item(it, r2); it += G;
    }
}

__device__ __forceinline__ void gdn_chain(const Params& p, int l, int b, int h, LAS unsigned char* lds, bool dummy = false) {
    const int tid = otid(), wave = tid >> 6, lane = tid & 63, r = lane & 15, q = lane >> 4;
    const int tok = tid >> 4, cg8 = (tid & 15) * 8;
    LAS bf16_t* sQ = (LAS bf16_t*)(lds + 0);
    LAS bf16_t* sK = (LAS bf16_t*)(lds + 8704);
    LAS bf16_t* sKb = (LAS bf16_t*)(lds + 17408);
    LAS bf16_t* sV = (LAS bf16_t*)(lds + 26112);
    LAS bf16_t* sVT = (LAS bf16_t*)(lds + 36352);
    LAS bf16_t* sVTs = (LAS bf16_t*)(lds + 46592);
    LAS bf16_t* sTb = (LAS bf16_t*)(lds + 56832);
    LAS bf16_t* sP = (LAS bf16_t*)(lds + 59392);
    LAS bf16_t* sSt = (LAS bf16_t*)(lds + 61952);
    LAS float* sAm = (LAS float*)(lds + 96768);
    LAS float* sO = (LAS float*)(lds + 101376);
    LAS float* sG = (LAS float*)(lds + 118272);
    LAS float* sCW = (LAS float*)(lds + 118400);
    LAS bf16_t* sA21 = (LAS bf16_t*)(lds + 124544);
    LAS bf16_t* sT11T = (LAS bf16_t*)(lds + 125824);
    LAS bf16_t* sT22 = (LAS bf16_t*)(lds + 127104);
    LAS bf16_t* sXT = (LAS bf16_t*)(lds + 128384);
    LAS bf16_t* sTbg = (LAS bf16_t*)(lds + 129664);
    LAS float* sBeta = (LAS float*)(lds + 132224);
    LAS float* sEgl = (LAS float*)(lds + 132352);
    bf16_t* proj = (bf16_t*)(p.ws + OFF_PROJ);
    const float* bg = (const float*)(p.ws + OFF_BG);
    for (int i = tid; i < 128 * 136 / 2; i += 512) ((LAS unsigned*)sSt)[i] = 0u;
    for (int i = tid; i < 4 * 16 * 40 / 2; i += 512) ((LAS unsigned*)sA21)[i] = 0u;
    for (int i = tid; i < 32 * 40 / 2; i += 512) { ((LAS unsigned*)sTb)[i] = 0u; ((LAS unsigned*)sTbg)[i] = 0u; }
    f32x4 Sacc[8];
#pragma unroll
    for (int i = 0; i < 8; ++i) Sacc[i] = (f32x4){0.f, 0.f, 0.f, 0.f};
    float gn[8];
#pragma unroll
    for (int e = 0; e < 8; ++e) gn[e] = p.gnorm_a[l * 128 + cg8 + e];
    __syncthreads();
    const size_t rowbase = (size_t)b * TT;
    const int tr = wave >> 2, vc0 = (wave & 3) * 2;
    const bf16_t* qkb = (const bf16_t*)(p.ws + OFF_HB); const bf16_t* vbb = (const bf16_t*)(p.ws + OFF_VB);
    u32x4 pq, pk, pv;
    { const size_t row = rowof(b, tok); pq = *(const u32x4*)(qkb + row * DM + h * 128 + cg8); pk = *(const u32x4*)(qkb + row * DM + 512 + h * 128 + cg8); pv = *(const u32x4*)(vbb + row * 512 + h * 128 + cg8); }
    float pgj = bg[rowof(b, (lane & 31)) * 8 + 4 + h], pbeta = bg[rowof(b, tok) * 8 + h];
    for (int c = 0; c < 65; ++c) {
        const int t0 = c * 32, t = t0 + tok; const bool valid = t < TT;
        float gj = pgj; const float beta = pbeta;
        { const int tj = t0 + 32 + (lane & 31), tn = t + 32; pgj = (tj < TT) ? bg[rowof(b, tj) * 8 + 4 + h] : 0.f; pbeta = (tn < TT) ? bg[rowof(b, tn) * 8 + h] : 0.f; }
#pragma unroll
        for (int d = 1; d < 32; d <<= 1) { const float tt = __shfl_up(gj, d, 32); if ((lane & 31) >= d) gj += tt; }
        const float Gt = __shfl(gj, tok, 64), glast = __shfl(gj, 31, 64);
        if (wave == 0 && lane < 32) sG[lane] = gj;
        bf16_t* const zp = proj + rowof(b, (valid ? t : 0)) * NP + C_AZ + h * 128 + cg8;
        const u32x4 zreg = *(const u32x4*)zp;
        {
            const u32x4 cq = pq, ck = pk, cvv = pv;
            const int tn = t + 32;
            pq = (u32x4){0u, 0u, 0u, 0u}; pk = pq; pv = pq;
            if (tn < TT) { const size_t row = rowof(b, tn); pq = *(const u32x4*)(qkb + row * DM + h * 128 + cg8); pk = *(const u32x4*)(qkb + row * DM + 512 + h * 128 + cg8); pv = *(const u32x4*)(vbb + row * 512 + h * 128 + cg8); }
            const float eGl = __expf(glast - Gt);
            *(LAS u32x4*)(sQ + tok * 136 + cg8) = cq;
            *(LAS u32x4*)(sK + tok * 136 + cg8) = ck;
            *(LAS u32x4*)(sV + tok * 136 + cg8) = cvv;
            if ((tid & 15) == 0) { sBeta[tok] = beta; sEgl[tok] = eGl; }
        }
        BAR_LDS();
        {
            const int w4 = wave & 3, ti = w4 >> 1, tj = w4 & 1;
            f32x4 a = (f32x4){0.f, 0.f, 0.f, 0.f};
            a = mma_tile<128>(a, (wave < 4 ? sK : sQ) + ti * 16 * 136, 136, sK + tj * 16 * 136, 136, r, q);
            const int jcol = tj * 16 + r; const float Gj = sG[jcol];
#pragma unroll
            for (int j = 0; j < 4; ++j) {
                const int i = ti * 16 + q * 4 + j; const float Gi = sG[i];
                const float dec = __expf(fminf(Gi - Gj, 0.f));
                if (wave < 4) { const float ab = a[j] * dec * sBeta[i]; sAm[jcol * 36 + i] = (i > jcol) ? ab : 0.f; if (w4 == 2) sA21[(i - 16) * 40 + jcol] = f2bf(ab); }
                else sP[i * 40 + jcol] = f2bf((i >= jcol) ? a[j] * dec : 0.f);
            }
        }
        BAR_LDS();
        if (wave == 0) {
            if (lane < 32) {
                const int blk = lane >> 4, cc = lane & 15;
                const LAS float* Ab = sAm + (16 * blk) * 36 + 16 * blk;
                const float bj = sBeta[16 * blk + cc], bgj = bj * __expf(sG[16 * blk + cc]);
                float xx[16];
#pragma unroll
                for (int i = 0; i < 16; ++i) xx[i] = (i == cc) ? 1.f : 0.f;
                f32x4 ar[2][4];
#pragma unroll
                for (int g = 0; g < 4; ++g) ar[0][g] = *(const volatile LAS f32x4*)(Ab + g * 4);
#pragma unroll
                for (int j = 0; j < 15; ++j) {
                    if (j + 1 < 15) {
#pragma unroll
                        for (int g = (j + 2) / 4; g < 4; ++g) ar[(j + 1) & 1][g] = *(const volatile LAS f32x4*)(Ab + (j + 1) * 36 + g * 4);
                    }
#pragma unroll
                    for (int i = j + 1; i < 16; ++i) xx[i] -= ar[j & 1][i >> 2][i & 3] * xx[j];
                }
#pragma unroll
                for (int i = 0; i < 16; ++i) { sTb[(16 * blk + i) * 40 + 16 * blk + cc] = f2bf(xx[i] * bj); sTbg[(16 * blk + i) * 40 + 16 * blk + cc] = f2bf(xx[i] * bgj); }
                if (blk == 0) {
                    float lo[8], hi[8];
#pragma unroll
                    for (int i = 0; i < 8; ++i) { lo[i] = xx[i]; hi[i] = xx[8 + i]; }
                    *(LAS u32x4*)(sT11T + cc * 40) = pack8(lo); *(LAS u32x4*)(sT11T + cc * 40 + 8) = pack8(hi);
                } else {
#pragma unroll
                    for (int i = 0; i < 16; ++i) sT22[i * 40 + cc] = f2bf(xx[i]);
                }
            }
            LDS_WAIT();
            const f32x4 X = mma_tile<32>((f32x4){0.f, 0.f, 0.f, 0.f}, sA21, 40, sT11T, 40, r, q);
            { u32x2 w; w.x = cvt_pk_bf16(X[0], X[1]); w.y = cvt_pk_bf16(X[2], X[3]); *(LAS u32x2*)(sXT + r * 40 + q * 4) = w; }
            LDS_WAIT();
            const f32x4 Y = mma_tile<32>((f32x4){0.f, 0.f, 0.f, 0.f}, sT22, 40, sXT, 40, r, q);
#pragma unroll
            for (int j = 0; j < 4; ++j) { const float bj = sBeta[r], bgj = bj * __expf(sG[r]); sTb[(16 + q * 4 + j) * 40 + r] = f2bf(-Y[j] * bj); sTbg[(16 + q * 4 + j) * 40 + r] = f2bf(-Y[j] * bgj); }
        }
        BAR_LDS();
        f32x4 au[2], ao[2];
        {
            const bf16x8 aTb = *(const LAS bf16x8*)(sTb + (tr * 16 + r) * 40 + q * 8), aTbg = *(const LAS bf16x8*)(sTbg + (tr * 16 + r) * 40 + q * 8);
#pragma unroll
            for (int x = 0; x < 2; ++x) {
                const int vc = vc0 + x;
                au[x] = __builtin_amdgcn_mfma_f32_16x16x32_bf16(aTb, frag_tr(sV, 136, 0, vc * 16, lane), (f32x4){0.f, 0.f, 0.f, 0.f}, 0, 0, 0);
                const f32x4 aw = __builtin_amdgcn_mfma_f32_16x16x32_bf16(aTbg, frag_tr(sK, 136, 0, vc * 16, lane), (f32x4){0.f, 0.f, 0.f, 0.f}, 0, 0, 0);
#pragma unroll
                for (int j = 0; j < 4; ++j) sKb[(tr * 16 + q * 4 + j) * 136 + vc * 16 + r] = f2bf(-aw[j]);
            }
        }
        BAR_LDS();
        {
            bf16x8 aW[4], aQ[4];
#pragma unroll
            for (int kk = 0; kk < 4; ++kk) { aW[kk] = *(const LAS bf16x8*)(sKb + (tr * 16 + r) * 136 + kk * 32 + q * 8); aQ[kk] = *(const LAS bf16x8*)(sQ + (tr * 16 + r) * 136 + kk * 32 + q * 8); }
            const f32x4 gi = *(const LAS f32x4*)(sG + tr * 16 + q * 4);
            const f32x4 eg = *(const LAS f32x4*)(sEgl + tr * 16 + q * 4);
#pragma unroll
            for (int x = 0; x < 2; ++x) {
                const int vc = vc0 + x;
                ao[x] = (f32x4){0.f, 0.f, 0.f, 0.f};
#pragma unroll
                for (int kk = 0; kk < 4; ++kk) {
                    const bf16x8 bS = *(const LAS bf16x8*)(sSt + (vc * 16 + r) * 136 + kk * 32 + q * 8);
                    au[x] = __builtin_amdgcn_mfma_f32_16x16x32_bf16(aW[kk], bS, au[x], 0, 0, 0);
                    ao[x] = __builtin_amdgcn_mfma_f32_16x16x32_bf16(aQ[kk], bS, ao[x], 0, 0, 0);
                }
#pragma unroll
                for (int j = 0; j < 4; ++j) ao[x][j] *= __expf(gi[j]);
                u32x2 w; w.x = cvt_pk_bf16(au[x][0], au[x][1]); w.y = cvt_pk_bf16(au[x][2], au[x][3]);
                *(LAS u32x2*)(sVT + (vc * 16 + r) * 40 + tr * 16 + q * 4) = w;
                u32x2 ws; ws.x = cvt_pk_bf16(au[x][0] * eg[0], au[x][1] * eg[1]); ws.y = cvt_pk_bf16(au[x][2] * eg[2], au[x][3] * eg[3]);
                *(LAS u32x2*)(sVTs + (vc * 16 + r) * 40 + tr * 16 + q * 4) = ws;
            }
        }
        BAR_LDS();
        {
            const bf16x8 aP = *(const LAS bf16x8*)(sP + (tr * 16 + r) * 40 + q * 8);
#pragma unroll
            for (int x = 0; x < 2; ++x) {
                const int vc = vc0 + x;
                const bf16x8 bV = *(const LAS bf16x8*)(sVT + (vc * 16 + r) * 40 + q * 8);
                ao[x] = __builtin_amdgcn_mfma_f32_16x16x32_bf16(aP, bV, ao[x], 0, 0, 0);
#pragma unroll
                for (int j = 0; j < 4; ++j) sO[(tr * 16 + q * 4 + j) * 132 + vc * 16 + r] = ao[x][j];
            }
        }
        {
            const float egl = __expf(glast);
            const bf16x8 bVs = *(const LAS bf16x8*)(sVTs + (wave * 16 + r) * 40 + q * 8);
            bf16x8 aK[8];
#pragma unroll
            for (int kr = 0; kr < 8; ++kr) aK[kr] = frag_tr(sK, 136, 0, kr * 16, lane);
#pragma unroll
            for (int kr = 0; kr < 8; ++kr) {
                Sacc[kr] = Sacc[kr] * egl;
                Sacc[kr] = __builtin_amdgcn_mfma_f32_16x16x32_bf16(aK[kr], bVs, Sacc[kr], 0, 0, 0);
                u32x2 w; w.x = cvt_pk_bf16(Sacc[kr][0], Sacc[kr][1]); w.y = cvt_pk_bf16(Sacc[kr][2], Sacc[kr][3]);
                *(LAS u32x2*)(sSt + (wave * 16 + r) * 136 + kr * 16 + q * 4) = w;
            }
        }
        BAR_LDS();
        {
            const f32x4 o0 = *(const LAS f32x4*)(sO + tok * 132 + cg8), o1 = *(const LAS f32x4*)(sO + tok * 132 + cg8 + 4);
            float ss = (o0[0] * o0[0] + o0[1] * o0[1]) + (o0[2] * o0[2] + o0[3] * o0[3]) + (o1[0] * o1[0] + o1[1] * o1[1]) + (o1[2] * o1[2] + o1[3] * o1[3]);
#pragma unroll
            for (int o = 1; o < 16; o <<= 1) ss += __shfl_xor(ss, o);
            const float rs = rsqrtf(ss * (1.0f / 128.0f) + EPS);
            if (valid) {
                float z[8], y[8]; unpack8(zreg, z);
#pragma unroll
                for (int e = 0; e < 4; ++e) { y[e] = o0[e] * rs * gn[e] * siluf_(z[e]); y[4 + e] = o1[e] * rs * gn[4 + e] * siluf_(z[4 + e]); }
                *(u32x4*)(dummy ? (bf16_t*)(p.ws + OFF_HB) + rowof(b, t) * DM + h * 128 + cg8 : zp) = pack8(y);
            }
        }
    }
    __syncthreads();
}

__device__ __forceinline__ void hgrn_chain(const Params& p, int l, int b, int h, LAS unsigned char* lds, bool dummy = false) {
    const int tid = otid(), wave = tid >> 6, lane = tid & 63, r = lane & 15, q = lane >> 4;
    const int tok = tid >> 4, cg8 = (tid & 15) * 8;
    LAS bf16_t* sQ = (LAS bf16_t*)(lds + 0);
    LAS bf16_t* sKh = (LAS bf16_t*)(lds + 8704);
    LAS bf16_t* sV = (LAS bf16_t*)(lds + 17408);
    LAS bf16_t* sKt = (LAS bf16_t*)(lds + 27648);
    LAS bf16_t* sSc = (LAS bf16_t*)(lds + 37888);
    LAS bf16_t* sSt = (LAS bf16_t*)(lds + 40448);
    LAS float* sF = (LAS float*)(lds + 75264);
    LAS float* sO = (LAS float*)(lds + 91648);
    LAS float* sEbl = (LAS float*)(lds + 108544);
    bf16_t* proj = (bf16_t*)(p.ws + OFF_PROJ);
    for (int i = tid; i < 128 * 136 / 2; i += 512) ((LAS unsigned*)sSt)[i] = 0u;
    f32x4 Sacc[8];
#pragma unroll
    for (int i = 0; i < 8; ++i) Sacc[i] = (f32x4){0.f, 0.f, 0.f, 0.f};
    float gn[8], lbv[8];
#pragma unroll
    for (int e = 0; e < 8; ++e) {
        gn[e] = p.gnorm_b[l * 128 + cg8 + e];
        const float x0 = p.lbraw[h * 128 + cg8 + e], x1 = p.lbraw[512 + h * 128 + cg8 + e], mx = fmaxf(x0, x1);
        const float e0 = __expf(x0 - mx), e1 = __expf(x1 - mx), s0 = e0 / (e0 + e1), s1 = e1 / (e0 + e1);
        lbv[e] = (l == 0) ? 0.f : ((s0 + s1) - s0);
    }
    __syncthreads();
    const size_t rowbase = (size_t)b * TT;
    const int tr = wave >> 2, vc0 = (wave & 3) * 2;
    u32x4 pq, pf, pi, pz;
    { const bf16_t* rn = proj + rowof(b, tok) * NP + h * 128 + cg8; pq = *(const u32x4*)(rn + C_BQ); pf = *(const u32x4*)(rn + C_BF); pi = *(const u32x4*)(rn + C_BI); pz = *(const u32x4*)(rn + C_BG); }
    for (int c = 0; c < 65; ++c) {
        const int t0 = c * 32, t = t0 + tok; const bool valid = t < TT;
        float qv[8], kk[8], vv[8], lf[8];
        const u32x4 cq = pq, cf = pf, ci = pi, cz = pz;
        { const int tn = t + 32; if (tn < TT) { const bf16_t* rn = proj + rowof(b, tn) * NP + h * 128 + cg8;
            pq = *(const u32x4*)(rn + C_BQ); pf = *(const u32x4*)(rn + C_BF); pi = *(const u32x4*)(rn + C_BI); pz = *(const u32x4*)(rn + C_BG); } }
        if (valid) {
            float zq[8], zf[8]; unpack8(cq, zq); unpack8(cf, zf); unpack8(ci, vv);
#pragma unroll
            for (int e = 0; e < 8; ++e) {
                qv[e] = siluf_(zq[e]) * 0.08838834764831845f;
                const float z = zf[e];
                const float en = __expf(-fabsf(z));
                const float rden = __builtin_amdgcn_rcpf(1.0f + en);
                const float logsig = fminf(z, 0.f) - __logf(1.0f + en);
                const float sig = (z >= 0.f ? 1.0f : en) * rden;
                const float nsig = (z >= 0.f ? en : 1.0f) * rden;
                const float lb = lbv[e];
                if (lb > 0.f) { lf[e] = __logf(lb + (1.0f - lb) * sig); kk[e] = (1.0f - lb) * nsig; }
                else { lf[e] = logsig; kk[e] = nsig; }
            }
        } else {
#pragma unroll
            for (int e = 0; e < 8; ++e) { qv[e] = 0.f; kk[e] = 0.f; vv[e] = 0.f; lf[e] = 0.f; }
        }
        *(LAS f32x4*)(sF + tok * 128 + cg8) = (f32x4){lf[0], lf[1], lf[2], lf[3]};
        *(LAS f32x4*)(sF + tok * 128 + cg8 + 4) = (f32x4){lf[4], lf[5], lf[6], lf[7]};
        BAR_LDS();
        if (tid < 128) { float cs[32];
#pragma unroll
            for (int i = 0; i < 32; ++i) cs[i] = sF[i * 128 + tid];
#pragma unroll
            for (int i = 1; i < 32; ++i) cs[i] += cs[i - 1];
#pragma unroll
            for (int i = 0; i < 32; ++i) sF[i * 128 + tid] = cs[i];
            sEbl[tid] = __expf(cs[31]); }
        BAR_LDS();
        {
            const f32x4 b0 = *(const LAS f32x4*)(sF + tok * 128 + cg8), b1 = *(const LAS f32x4*)(sF + tok * 128 + cg8 + 4);
            const f32x4 l0 = *(const LAS f32x4*)(sEbl + cg8), l1 = *(const LAS f32x4*)(sEbl + cg8 + 4);
            float qt[8], kh[8], kt[8];
#pragma unroll
            for (int e = 0; e < 8; ++e) {
                const float bc = e < 4 ? b0[e & 3] : b1[e & 3], ebl = e < 4 ? l0[e & 3] : l1[e & 3];
                const float ebc = __expf(bc);
                qt[e] = qv[e] * ebc; kh[e] = kk[e] * __builtin_amdgcn_rcpf(ebc);
                kt[e] = kh[e] * ebl;
            }
            *(LAS u32x4*)(sKt + tok * 136 + cg8) = pack8(kt);
            *(LAS u32x4*)(sV + tok * 136 + cg8) = pack8(vv);
            *(LAS u32x4*)(sQ + tok * 136 + cg8) = pack8(qt);
            *(LAS u32x4*)(sKh + tok * 136 + cg8) = pack8(kh);
        }
        BAR_LDS();
        if (wave < 4) {
            const int ti = wave >> 1, tj = wave & 1;
            const f32x4 a = mma_tile<128>((f32x4){0.f, 0.f, 0.f, 0.f}, sQ + ti * 16 * 136, 136, sKh + tj * 16 * 136, 136, r, q);
            const int jcol = tj * 16 + r;
#pragma unroll
            for (int j = 0; j < 4; ++j) { const int i = ti * 16 + q * 4 + j; sSc[i * 40 + jcol] = f2bf((i >= jcol) ? a[j] : 0.f); }
        }
        f32x4 ao[2];
        {
            bf16x8 aQ[4];
#pragma unroll
            for (int kk = 0; kk < 4; ++kk) aQ[kk] = *(const LAS bf16x8*)(sQ + (tr * 16 + r) * 136 + kk * 32 + q * 8);
#pragma unroll
            for (int x = 0; x < 2; ++x) {
                ao[x] = (f32x4){0.f, 0.f, 0.f, 0.f};
#pragma unroll
                for (int kk = 0; kk < 4; ++kk) ao[x] = __builtin_amdgcn_mfma_f32_16x16x32_bf16(aQ[kk], *(const LAS bf16x8*)(sSt + ((vc0 + x) * 16 + r) * 136 + kk * 32 + q * 8), ao[x], 0, 0, 0);
            }
        }
        BAR_LDS();
        {
            const bf16x8 aSc = *(const LAS bf16x8*)(sSc + (tr * 16 + r) * 40 + q * 8);
#pragma unroll
            for (int x = 0; x < 2; ++x) {
                const int vc = vc0 + x;
                ao[x] = __builtin_amdgcn_mfma_f32_16x16x32_bf16(aSc, frag_tr(sV, 136, 0, vc * 16, lane), ao[x], 0, 0, 0);
#pragma unroll
                for (int j = 0; j < 4; ++j) sO[(tr * 16 + q * 4 + j) * 132 + vc * 16 + r] = ao[x][j];
            }
        }
        {
            const bf16x8 bV = frag_tr(sV, 136, 0, wave * 16, lane);
            bf16x8 aK[8];
#pragma unroll
            for (int kr = 0; kr < 8; ++kr) aK[kr] = frag_tr(sKt, 136, 0, kr * 16, lane);
#pragma unroll
            for (int kr = 0; kr < 8; ++kr) {
                const f32x4 ebl = *(const LAS f32x4*)(sEbl + kr * 16 + q * 4);
                Sacc[kr] = Sacc[kr] * ebl;
                Sacc[kr] = __builtin_amdgcn_mfma_f32_16x16x32_bf16(aK[kr], bV, Sacc[kr], 0, 0, 0);
                u32x2 w; w.x = cvt_pk_bf16(Sacc[kr][0], Sacc[kr][1]); w.y = cvt_pk_bf16(Sacc[kr][2], Sacc[kr][3]);
                *(LAS u32x2*)(sSt + (wave * 16 + r) * 136 + kr * 16 + q * 4) = w;
            }
        }
        BAR_LDS();
        {
            const f32x4 o0 = *(const LAS f32x4*)(sO + tok * 132 + cg8), o1 = *(const LAS f32x4*)(sO + tok * 132 + cg8 + 4);
            float ss = (o0[0] * o0[0] + o0[1] * o0[1]) + (o0[2] * o0[2] + o0[3] * o0[3]) + (o1[0] * o1[0] + o1[1] * o1[1]) + (o1[2] * o1[2] + o1[3] * o1[3]);
#pragma unroll
            for (int o = 1; o < 16; o <<= 1) ss += __shfl_xor(ss, o);
            const float rs = rsqrtf(ss * (1.0f / 128.0f) + EPS);
            if (valid) {
                bf16_t* zp = proj + rowof(b, t) * NP + C_BG + h * 128 + cg8;
                float z[8], y[8]; unpack8(cz, z);
#pragma unroll
                for (int e = 0; e < 4; ++e) { y[e] = o0[e] * rs * gn[e] * siluf_(z[e]); y[4 + e] = o1[e] * rs * gn[4 + e] * siluf_(z[4 + e]); }
                *(u32x4*)(dummy ? (bf16_t*)(p.ws + OFF_HB) + rowof(b, t) * DM + 512 + h * 128 + cg8 : zp) = pack8(y);
            }
        }
    }
    __syncthreads();
}

__device__ __forceinline__ void final_phase(const Params& p) {
    const int tid = otid(), wave = tid >> 6, lane = tid & 63;
    const int gw = blockIdx.x * 8 + wave, NGW = gridDim.x * 8;
    const float* sumsq = (const float*)(p.ws + OFF_SUMSQ) + (size_t)2 * MROWS;
    f32x4 w[4];
#pragma unroll
    for (int j = 0; j < 4; ++j) w[j] = *(const f32x4*)(p.fnw + 4 * lane + 256 * j);
    f32x4 vn[4]; float nss = 0.f;
    if (gw < NBATCH * SEQ) { nss = sumsq[gw];
#pragma unroll
        for (int j = 0; j < 4; ++j) vn[j] = *(const f32x4*)(p.out + (size_t)gw * DM + 4 * lane + 256 * j); }
    for (int rr = gw; rr < NBATCH * SEQ; rr += NGW) {
        f32x4 v[4]; const float css = nss;
#pragma unroll
        for (int j = 0; j < 4; ++j) v[j] = vn[j];
        if (rr + NGW < NBATCH * SEQ) { const size_t rn = (size_t)(rr + NGW); nss = sumsq[rn];
#pragma unroll
            for (int j = 0; j < 4; ++j) vn[j] = *(const f32x4*)(p.out + rn * DM + 4 * lane + 256 * j); }
        const float rs = rsqrtf(css * (1.0f / DM) + EPS);
        float* op = p.out + (size_t)rr * DM + 4 * lane;
#pragma unroll
        for (int j = 0; j < 4; ++j) *(f32x4*)(op + 256 * j) = v[j] * rs * w[j];
    }
}

template <int K>
__device__ __forceinline__ void run_phase(const Params& p, int l, LAS unsigned char* lds) {
    bf16_t* proj = (bf16_t*)(p.ws + OFF_PROJ); bf16_t* hb = (bf16_t*)(p.ws + OFF_HB);
    float* sumsq = (float*)(p.ws + OFF_SUMSQ);
    if constexpr (K == 0) phase0(p, lds);
    else if constexpr (K == 1) {
        bg_pass(p, l);
        pg8::Gemm g{hb, (const bf16_t*)(p.ws + OFF_W1T) + (size_t)l * NP * DM, MROWS, NP, DM, DM, DM};
        pg8::StaticOrder S; S.init(g.M, g.N, (int)gridDim.x, (int)blockIdx.x);
        pg8::EpiProj E{proj, sumsq + (size_t)l * MROWS};
        pg8::gemm_phase(lds, g, S, E);
    } else if constexpr (K == 6) {
        gdn_prep(p, l, lds);
    } else if constexpr (K == 2) {
        for (int ch = blockIdx.x; ch < 256; ch += gridDim.x) {
            if (ch < 128) gdn_chain(p, l, ch >> 2, ch & 3, lds);
            else hgrn_chain(p, l, (ch - 128) >> 2, ch & 3, lds);
        }
    } else if constexpr (K == 3) {
        const bf16_t* W23 = (const bf16_t*)(p.ws + OFF_W23T) + (size_t)l * DM * DM;
        const int Mrows = l == 1 ? NREAL : MROWS;
        pg8::StaticOrder S; S.init(Mrows, DM, (int)gridDim.x, (int)blockIdx.x);
        { pg8::Gemm g{proj + C_AZ, W23, Mrows, DM, 512, NP, DM}; pg8::EpiMix<0> E{proj}; pg8::gemm_phase(lds, g, S, E); }
        __builtin_amdgcn_fence(__ATOMIC_SEQ_CST, "workgroup");
        { pg8::Gemm g{proj + C_BG, W23 + 512, Mrows, DM, 512, NP, DM}; pg8::EpiMix<1> E{proj}; pg8::gemm_phase(lds, g, S, E); }
    } else if constexpr (K == 4) {
        pg8::Gemm g{proj, (const bf16_t*)(p.ws + OFF_W4T) + (size_t)l * DM * DM, l == 1 ? NREAL : MROWS, DM, DM, NP, DM};
        pg8::StaticOrder S; S.init(g.M, g.N, (int)gridDim.x, (int)blockIdx.x);
        pg8::EpiOut E{l, p.x, p.meta, p.out, (float*)(p.ws + OFF_HMETA), hb, sumsq + (size_t)(l + 1) * MROWS};
        pg8::gemm_phase(lds, g, S, E);
    } else final_phase(p);
}

#define XB_TMO      128
#define XB_XCNT(j)  (256  + 64 * (j))
#define XB_XSUB(j)  (1280 + 64 * (j))
#define XB_XGEN(j)  (2304 + 64 * (j))
#define XB_TOP      3328
#define XB_TOPGEN   3392
#define XCD_BAR_WORDS 3456
#define XB_SPIN_CAP (1u << 18)
__device__ __forceinline__ unsigned xb_ld(unsigned* p)              { return __hip_atomic_load(p, __ATOMIC_RELAXED, __HIP_MEMORY_SCOPE_AGENT); }
__device__ __forceinline__ unsigned xb_add(unsigned* p, unsigned v) { return __hip_atomic_fetch_add(p, v, __ATOMIC_RELAXED, __HIP_MEMORY_SCOPE_AGENT); }
__device__ __forceinline__ unsigned xb_xcc_id() { return (unsigned)__builtin_amdgcn_s_getreg((3 << 11) | 20) & 0xFu; }
#define XB_SPIN(cond, bar) do { unsigned _sp = 0; while (cond) { __builtin_amdgcn_s_sleep(1); \
    if ((++_sp & 255u) == 0u) { if (xb_ld(&(bar)[XB_TMO])) break; if (_sp > XB_SPIN_CAP) { atomicAdd(&(bar)[XB_TMO], 1u); break; } } } } while (0)
struct XcdBarrier { unsigned* bar; unsigned x; volatile LAS unsigned* st; };
__device__ __forceinline__ XcdBarrier xcd_barrier_post(unsigned* bar, volatile LAS unsigned* st) {
    XcdBarrier b; b.bar = bar; b.x = xb_xcc_id(); b.st = st;
    if (threadIdx.x == 0) (void)xb_add(&bar[XB_XCNT(b.x)], 1u);
    return b;
}
__device__ __forceinline__ void xcd_barrier_complete(unsigned* bar, unsigned x, unsigned& nloc, unsigned& nx) {
    const unsigned G = gridDim.x * gridDim.y * gridDim.z;
    unsigned sum, cnt, mine, sp = 0u;
    for (;;) {
        sum = 0u; cnt = 0u; mine = 0u;
#pragma unroll
        for (unsigned j = 0; j < 16; ++j) { const unsigned c = xb_ld(&bar[XB_XCNT(j)]); sum += c; cnt += (c > 0u) ? 1u : 0u; mine = (j == x) ? c : mine; }
        if (sum == G) break;
        __builtin_amdgcn_s_sleep(1);
        if ((++sp & 255u) == 0u) { if (xb_ld(&bar[XB_TMO])) break; if (sp > XB_SPIN_CAP) { atomicAdd(&bar[XB_TMO], 1u); break; } }
    }
    nloc = mine > 0u ? mine : 1u; nx = cnt > 0u ? cnt : 1u;
}
__device__ __forceinline__ void xcd_barrier(const XcdBarrier& b) {
    asm volatile("s_waitcnt vmcnt(0)" ::: "memory");
    __syncthreads();
    if (threadIdx.x == 0) {
        unsigned* bar = b.bar;
        __builtin_amdgcn_s_waitcnt(0);
        unsigned nloc = b.st[0], nx = b.st[1];
        if (nloc == 0u) { xcd_barrier_complete(bar, b.x, nloc, nx); b.st[0] = nloc; b.st[1] = nx; }
        const unsigned old = xb_add(&bar[XB_XSUB(b.x)], 1u);
        const unsigned gen = old / nloc;
        if (old + 1u == (gen + 1u) * nloc) {
            __builtin_amdgcn_fence(__ATOMIC_RELEASE, "agent");
            asm volatile("s_waitcnt vmcnt(0)" ::: "memory");
            const unsigned og = xb_add(&bar[XB_TOP], 1u);
            const unsigned tg = og / nx;
            if (og + 1u == (tg + 1u) * nx) xb_add(&bar[XB_TOPGEN], 1u);
            else XB_SPIN(xb_ld(&bar[XB_TOPGEN]) == tg, bar);
            __builtin_amdgcn_fence(__ATOMIC_ACQUIRE, "agent");
            xb_add(&bar[XB_XGEN(b.x)], 1u);
            asm volatile("s_waitcnt vmcnt(0)" ::: "memory");
        } else {
            XB_SPIN(xb_ld(&bar[XB_XGEN(b.x)]) == gen, bar);
            __builtin_amdgcn_fence(__ATOMIC_ACQUIRE, "agent");
            asm volatile("s_waitcnt vmcnt(0)" ::: "memory");
        }
    }
    __syncthreads();
}

#if MEGA
__global__ void __launch_bounds__(512, 2) fwd_kernel(Params p) {
    extern __shared__ __attribute__((aligned(16))) unsigned char smem[];
    LAS unsigned char* lds = (LAS unsigned char*)smem;
    cg::grid_group grid = cg::this_grid();
    volatile LAS unsigned* xst = (volatile LAS unsigned*)(lds + LDS_BYTES - 16);
    if (threadIdx.x < 4) xst[threadIdx.x] = 0u;
    __syncthreads();
    const XcdBarrier xb = xcd_barrier_post((unsigned*)(p.ws + OFF_XBAR), xst);
    run_phase<0>(p, 0, lds); grid.sync();
#pragma unroll 1
    for (int l = 0; l < 2; ++l) {
        run_phase<1>(p, l, lds); xcd_barrier(xb);
        run_phase<6>(p, l, lds); xcd_barrier(xb);
        run_phase<2>(p, l, lds); xcd_barrier(xb);
        run_phase<3>(p, l, lds); xcd_barrier(xb);
        run_phase<4>(p, l, lds); xcd_barrier(xb);
    }
    run_phase<5>(p, 0, lds);
}
#else
template <int K>
__global__ void __launch_bounds__(512, 2) k_phase(Params p, int l) {
    extern __shared__ __attribute__((aligned(16))) unsigned char smem[];
    run_phase<K>(p, l, (LAS unsigned char*)smem);
}
#endif

template <int K> static void launch_phase(const Params& p, int l, int grid, hipStream_t stream) {
#if !MEGA
    static bool attr = false;
    if (!attr) { if (hipFuncSetAttribute((const void*)k_phase<K>, hipFuncAttributeMaxDynamicSharedMemorySize, LDS_BYTES) != hipSuccess) fprintf(stderr, "hipFuncSetAttribute failed (phase %d)\n", K); attr = true; }
    hipLaunchKernelGGL((k_phase<K>), dim3(grid), dim3(512), LDS_BYTES, stream, p, l);
#endif
}

extern "C" void kernel_launch(void* const* d_in, const int* in_sizes, int n_in, void* d_out, int out_size, void* d_ws, size_t ws_size, hipStream_t stream) {
    static int grid = 0;
    if (grid == 0) {
        if (n_in != 14 || ws_size < WS_END) { fprintf(stderr, "kernel_launch: unexpected n_in %d / ws %zu (need %zu)\n", n_in, ws_size, (size_t)WS_END); grid = -1; return; }
        int dev = 0, cus = 0;
        (void)hipGetDevice(&dev);
        (void)hipDeviceGetAttribute(&cus, hipDeviceAttributeMultiprocessorCount, dev);
#if MEGA
        int per_cu = 0;
        if (hipFuncSetAttribute((const void*)fwd_kernel, hipFuncAttributeMaxDynamicSharedMemorySize, LDS_BYTES) != hipSuccess) fprintf(stderr, "kernel_launch: hipFuncSetAttribute failed\n");
        if (hipOccupancyMaxActiveBlocksPerMultiprocessor(&per_cu, (const void*)fwd_kernel, 512, LDS_BYTES) != hipSuccess || per_cu < 1) fprintf(stderr, "kernel_launch: occupancy query says %d\n", per_cu);
        (void)hipGetLastError();
#endif
        grid = cus;
        if (grid > 256 || grid < 1) grid = 256;
    }
    if (grid < 0) return;
    Params p{};
    p.x = (const float*)d_in[0]; p.meta = (const float*)d_in[1]; p.norm_w = (const float*)d_in[2]; p.w_in = (const float*)d_in[3]; p.conv_w = (const float*)d_in[4];
    p.a_log = (const float*)d_in[5]; p.dt_bias = (const float*)d_in[6]; p.gnorm_a = (const float*)d_in[7]; p.gnorm_b = (const float*)d_in[8]; p.lbraw = (const float*)d_in[9];
    p.wba = (const float*)d_in[10]; p.wbb = (const float*)d_in[11]; p.wout = (const float*)d_in[12]; p.fnw = (const float*)d_in[13];
    p.out = (float*)d_out; p.ws = (unsigned char*)d_ws;
#if MEGA
    (void)hipMemsetAsync((unsigned char*)d_ws + OFF_XBAR, 0, 16384, stream);
    void* args[] = {&p};
    hipError_t e = hipLaunchCooperativeKernel((const void*)fwd_kernel, dim3(grid), dim3(512), args, LDS_BYTES, stream);
    if (e != hipSuccess) fprintf(stderr, "cooperative launch failed: %s (grid %d)\n", hipGetErrorString(e), grid);
#else
    launch_phase<0>(p, 0, grid, stream);
    for (int l = 0; l < 2; ++l) { launch_phase<1>(p, l, grid, stream); launch_phase<6>(p, l, grid, stream); launch_phase<2>(p, l, grid, stream); launch_phase<3>(p, l, grid, stream); launch_phase<4>(p, l, grid, stream); }
    launch_phase<5>(p, 0, grid, stream);
#endif
}
```

```cpp
#include <hip/hip_runtime.h>
#include <hip/hip_cooperative_groups.h>
#include <cstdio>
namespace cg = cooperative_groups;

#ifndef PROBE_SCAN
#define PROBE_SCAN 0
#endif
#ifndef PROBE_G1
#define PROBE_G1 0
#endif
#ifndef MEGA
#define MEGA 1
#endif

#define LAS __attribute__((address_space(3)))
typedef unsigned short bf16_t;
typedef short bf16x8 __attribute__((ext_vector_type(8)));
typedef float f32x4 __attribute__((ext_vector_type(4)));
typedef unsigned u32x4 __attribute__((ext_vector_type(4)));
typedef unsigned u32x2 __attribute__((ext_vector_type(2)));

constexpr int DM = 1024, NBATCH = 32, SEQ = 2048, NMETA = 16, TT = SEQ + NMETA, MROWS = NBATCH * TT, NP = 6144, WIN = 6152;
constexpr float EPS = 1e-6f;
constexpr int NREAL = NBATCH * SEQ;
constexpr int C_AQ = 0, C_AK = 512, C_AV = 1024, C_BQ = 1536, C_BF = 2048, C_BI = 2560, C_AZ = 3072, C_BG = 3584, C_GA = 4096, C_GB = 5120;
constexpr size_t OFF_PROJ = 0;
constexpr size_t OFF_HB = OFF_PROJ + (size_t)MROWS * NP * 2;
constexpr size_t OFF_W1T = OFF_HB + (size_t)MROWS * DM * 2;
constexpr size_t OFF_W23T = OFF_W1T + (size_t)2 * NP * DM * 2;
constexpr size_t OFF_W4T = OFF_W23T + (size_t)2 * DM * DM * 2;
constexpr size_t OFF_W8 = OFF_W4T + (size_t)2 * DM * DM * 2;
constexpr size_t OFF_SUMSQ = OFF_W8 + (size_t)2 * 8 * DM * 4;
constexpr size_t OFF_BG = OFF_SUMSQ + (size_t)3 * MROWS * 4;
constexpr size_t OFF_HMETA = OFF_BG + (size_t)MROWS * 8 * 4;
constexpr size_t OFF_VB = OFF_HMETA + (size_t)NBATCH * NMETA * DM * 4;
constexpr size_t OFF_XBAR = OFF_VB + (size_t)MROWS * 512 * 2;
constexpr size_t WS_END = OFF_XBAR + 16384;
constexpr int LDS_BYTES = 133120;

struct Params {
    const float *x, *meta, *norm_w, *w_in, *conv_w, *a_log, *dt_bias, *gnorm_a, *gnorm_b, *lbraw, *wba, *wbb, *wout, *fnw;
    float* out;
    unsigned char* ws;
};

typedef __bf16 bf16x2_t __attribute__((ext_vector_type(2)));
__device__ __forceinline__ unsigned cvt_pk_bf16(float lo, float hi) { bf16x2_t v; v[0] = (__bf16)lo; v[1] = (__bf16)hi; return __builtin_bit_cast(unsigned, v); }
__device__ __forceinline__ bf16_t f2bf(float f) { return (bf16_t)(cvt_pk_bf16(f, 0.f) & 0xffffu); }
__device__ __forceinline__ float bflo(unsigned w) { return __uint_as_float(w << 16); }
__device__ __forceinline__ float bfhi(unsigned w) { return __uint_as_float(w & 0xffff0000u); }
__device__ __forceinline__ void unpack8(const u32x4 w, float (&o)[8]) {
    o[0] = bflo(w.x); o[1] = bfhi(w.x); o[2] = bflo(w.y); o[3] = bfhi(w.y); o[4] = bflo(w.z); o[5] = bfhi(w.z); o[6] = bflo(w.w); o[7] = bfhi(w.w);
}
__device__ __forceinline__ u32x4 pack8(const float (&v)[8]) {
    u32x4 w; w.x = cvt_pk_bf16(v[0], v[1]); w.y = cvt_pk_bf16(v[2], v[3]); w.z = cvt_pk_bf16(v[4], v[5]); w.w = cvt_pk_bf16(v[6], v[7]); return w;
}
__device__ __forceinline__ float sigmoidf_(float x) { return __builtin_amdgcn_rcpf(1.0f + __expf(-x)); }
__device__ __forceinline__ float siluf_(float x) { return x * __builtin_amdgcn_rcpf(1.0f + __expf(-x)); }
__device__ __forceinline__ float softplusf_(float x) { return fmaxf(x, 0.f) + log1pf(__expf(-fabsf(x))); }
__device__ __forceinline__ float wave_sum(float v) {
#pragma unroll
    for (int o = 1; o < 64; o <<= 1) v += __shfl_xor(v, o);
    return v;
}
__device__ __forceinline__ size_t rowof(int b, int t) { return t < NMETA ? (size_t)(NREAL + b * NMETA + t) : (size_t)b * SEQ + (size_t)(t - NMETA); }
#define LDS_WAIT() asm volatile("s_waitcnt lgkmcnt(0)" ::: "memory")
#define BAR_LDS() do { asm volatile("s_waitcnt lgkmcnt(0)" ::: "memory"); __builtin_amdgcn_s_barrier(); asm volatile("" ::: "memory"); } while (0)
__device__ __forceinline__ int otid() { int t = threadIdx.x; asm volatile("" : "+v"(t)); return t; }
__device__ __forceinline__ int obid() { int t = blockIdx.x; asm volatile("" : "+s"(t)); return t; }
__device__ __forceinline__ int ogrid() { int t = gridDim.x; asm volatile("" : "+s"(t)); return t; }

template <int KT>
__device__ __forceinline__ f32x4 mma_tile(f32x4 acc, const LAS bf16_t* A, int lda, const LAS bf16_t* B, int ldb, int r, int q) {
#pragma unroll
    for (int kk = 0; kk < KT; kk += 32) {
        const bf16x8 a = *(const LAS bf16x8*)(A + r * lda + kk + q * 8);
        const bf16x8 b = *(const LAS bf16x8*)(B + r * ldb + kk + q * 8);
        acc = __builtin_amdgcn_mfma_f32_16x16x32_bf16(a, b, acc, 0, 0, 0);
    }
    return acc;
}

typedef short s16x4 __attribute__((ext_vector_type(4)));
__device__ __forceinline__ bf16x8 frag_tr(const LAS bf16_t* T, int ld, int kbase, int cbase, int lane) {
    const int g = lane >> 4, qq = (lane & 15) >> 2, pp = lane & 3;
    const LAS bf16_t* p0 = T + (kbase + 8 * g + qq) * ld + cbase + 4 * pp;
    const s16x4 a = __builtin_amdgcn_ds_read_tr16_b64_v4i16((LAS s16x4*)p0);
    const s16x4 b = __builtin_amdgcn_ds_read_tr16_b64_v4i16((LAS s16x4*)(p0 + 4 * ld));
    return (bf16x8){a[0], a[1], a[2], a[3], b[0], b[1], b[2], b[3]};
}
template <int KT>
__device__ __forceinline__ f32x4 mma_tile_trB(f32x4 acc, const LAS bf16_t* A, int lda, const LAS bf16_t* Tb, int ldb, int n0, int lane) {
    const int r = lane & 15, q = lane >> 4;
#pragma unroll
    for (int kk = 0; kk < KT; kk += 32) {
        const bf16x8 a = *(const LAS bf16x8*)(A + r * lda + kk + q * 8);
        const bf16x8 b = frag_tr(Tb, ldb, kk, n0, lane);
        acc = __builtin_amdgcn_mfma_f32_16x16x32_bf16(a, b, acc, 0, 0, 0);
    }
    return acc;
}
template <int KT>
__device__ __forceinline__ f32x4 mma_tile_trA(f32x4 acc, const LAS bf16_t* Ta, int lda, int m0, const LAS bf16_t* B, int ldb, int lane) {
    const int r = lane & 15, q = lane >> 4;
#pragma unroll
    for (int kk = 0; kk < KT; kk += 32) {
        const bf16x8 a = frag_tr(Ta, lda, kk, m0, lane);
        const bf16x8 b = *(const LAS bf16x8*)(B + r * ldb + kk + q * 8);
        acc = __builtin_amdgcn_mfma_f32_16x16x32_bf16(a, b, acc, 0, 0, 0);
    }
    return acc;
}
template <int KT>
__device__ __forceinline__ f32x4 mma_tile_trAB(f32x4 acc, const LAS bf16_t* Ta, int lda, int m0, const LAS bf16_t* Tb, int ldb, int n0, int lane) {
#pragma unroll
    for (int kk = 0; kk < KT; kk += 32) {
        const bf16x8 a = frag_tr(Ta, lda, kk, m0, lane);
        const bf16x8 b = frag_tr(Tb, ldb, kk, n0, lane);
        acc = __builtin_amdgcn_mfma_f32_16x16x32_bf16(a, b, acc, 0, 0, 0);
    }
    return acc;
}

namespace pg8 {
constexpr int BM = 256, BK = 64, HALF = 128, HTB = HALF * BK * 2, NXCD = 8, WGM = 8;
__device__ __forceinline__ int lds_byte(int r, int c) { const int st = (r >> 4) * 2 + (c >> 5), rr = r & 15, cc = c & 31, ob = rr * 64 + cc * 2; return st * 1024 + (ob ^ (((ob >> 9) & 1) << 5)); }
__device__ __forceinline__ void stage_rc(int b, int& R, int& C) { const int st = b / 1024, sb = b % 1024, swz = sb ^ (((sb >> 9) & 1) << 5); R = (st >> 1) * 16 + swz / 64; C = (st & 1) * 32 + (swz % 64) / 2; }
__device__ __forceinline__ int perm32(int rho) { const int n = rho >> 4, i = rho & 15; return 8 * (i >> 2) + 4 * n + (i & 3); }
struct Unit { int pm, pn; };
struct Gemm { const bf16_t* A; const bf16_t* Bt; int M, N, K, lda, ldb; };
struct StaticOrder {
    int nM, nN, nwg, G, c;
    __device__ void init(int M, int N, int G_, int c_) { nM = M / BM; nN = N / BM; nwg = nM * nN; G = G_; c = c_; }
    __device__ bool next(int i, Unit& u) const {
        const long L = (long)i * G + c; if (L >= nwg) return false;
        int wgid = (int)L; { const int q = nwg / NXCD, r = nwg % NXCD, xcd = wgid % NXCD, off = wgid / NXCD; wgid = (xcd < r ? xcd * (q + 1) : r * (q + 1) + (xcd - r) * q) + off; }
        const int nig = WGM * nN, gid = wgid / nig, fm = gid * WGM, gsz = (nM - fm) < WGM ? (nM - fm) : WGM;
        u.pm = fm + ((wgid % nig) % gsz); u.pn = (wgid % nig) / gsz; return true;
    }
};

template <class Epi>
__device__ __forceinline__ void gemm_phase(LAS unsigned char* lds, const Gemm g, const StaticOrder& S, const Epi& E) {
    const int tid = otid(), wid = __builtin_amdgcn_readfirstlane(tid >> 6), lane = tid & 63, wr = wid >> 2, wc = wid & 3, fr = lane & 15, fq = lane >> 4;
    const int K = g.K, nt = K / BK;
    unsigned voffA[2], voffB[2];
#pragma unroll
    for (int i = 0; i < 2; ++i) { int R, C; stage_rc(tid * 16 + i * 8192, R, C); const int Rb = (R & ~31) + perm32(R & 31);
        voffA[i] = (unsigned)(R * g.lda + C) * 2u; voffB[i] = (unsigned)(Rb * g.ldb + C) * 2u; }
    const size_t kstep = (size_t)(BK * 2);
    const size_t hstepA = (size_t)HALF * g.lda * 2, hstepB = (size_t)HALF * g.ldb * 2;
    const size_t tstepA = 2 * hstepA, tstepB = 2 * hstepB;
    const unsigned ldsw = (unsigned)wid * 1024u;
    const int aoff = lds_byte(wr * 64 + fr, fq * 8), boff = lds_byte(wc * 32 + fr, fq * 8);
#define PG8_SA(b, h) (((b) * 2 + (h)) * HTB)
#define PG8_SB(b, h) ((4 + (b) * 2 + (h)) * HTB)
#define PG8_STAGE(bufoff, gbase, voff) do { _Pragma("unroll") for (int _i = 0; _i < 2; ++_i) \
        __builtin_amdgcn_global_load_lds((const unsigned*)((const char*)(gbase) + (voff)[_i]), (LAS unsigned*)(lds + (bufoff) + ldsw + _i * 8192), 16, 0, 0); } while (0)
#define PG8_LDA(dst, b, h) do { _Pragma("unroll") for (int m = 0; m < 4; ++m) _Pragma("unroll") for (int k = 0; k < 2; ++k) dst[m][k] = *(const LAS bf16x8*)(lds + PG8_SA(b, h) + aoff + m * 2048 + k * 1024); } while (0)
#define PG8_LDB(dst, b, h) do { _Pragma("unroll") for (int n = 0; n < 2; ++n) _Pragma("unroll") for (int k = 0; k < 2; ++k) dst[n][k] = *(const LAS bf16x8*)(lds + PG8_SB(b, h) + boff + n * 2048 + k * 1024); } while (0)
#define PG8_MMA(ai, bj, At, Bt) do { __builtin_amdgcn_s_setprio(1); _Pragma("unroll") for (int m = 0; m < 4; ++m) _Pragma("unroll") for (int n = 0; n < 2; ++n) _Pragma("unroll") for (int k = 0; k < 2; ++k) \
        acc[ai][bj][m][n] = __builtin_amdgcn_mfma_f32_16x16x32_bf16(Bt[n][k], At[m][k], acc[ai][bj][m][n], 0, 0, 0); __builtin_amdgcn_s_setprio(0); } while (0)
#define PG8_WAIT_V(n) asm volatile("s_waitcnt vmcnt(" #n ")" ::: "memory")
#define PG8_WAIT_L(n) asm volatile("s_waitcnt lgkmcnt(" #n ")" ::: "memory")
#define PG8_BAR __builtin_amdgcn_s_barrier()
#define PG8_SCHED __builtin_amdgcn_sched_barrier(0)
    Unit cur, nxt; int ui = 0;
    if (!S.next(0, cur)) return;
    f32x4 acc[2][2][4][2];
#pragma unroll
    for (int a = 0; a < 2; ++a)
#pragma unroll
        for (int b = 0; b < 2; ++b)
#pragma unroll
            for (int m = 0; m < 4; ++m)
#pragma unroll
                for (int n = 0; n < 2; ++n) acc[a][b][m][n] = (f32x4){0.f, 0.f, 0.f, 0.f};
    bf16x8 At[4][2], B0[2][2], B1[2][2];
    const char* cA = (const char*)g.A + (size_t)cur.pm * tstepA; const char* cB = (const char*)g.Bt + (size_t)cur.pn * tstepB;
    PG8_STAGE(PG8_SB(0, 0), cB, voffB); PG8_STAGE(PG8_SA(0, 0), cA, voffA); PG8_STAGE(PG8_SB(0, 1), cB + hstepB, voffB); PG8_STAGE(PG8_SA(0, 1), cA + hstepA, voffA);
    if (wr == 1) PG8_BAR;
    PG8_WAIT_V(4); PG8_BAR;
    PG8_STAGE(PG8_SB(1, 0), cB + kstep, voffB); PG8_STAGE(PG8_SA(1, 0), cA + kstep, voffA); PG8_STAGE(PG8_SB(1, 1), cB + hstepB + kstep, voffB);
    PG8_WAIT_V(6); PG8_BAR;
    for (;;) {
        const bool has_next = S.next(ui + 1, nxt);
        const char* nA = has_next ? (const char*)g.A + (size_t)nxt.pm * tstepA : cA; const char* nB = has_next ? (const char*)g.Bt + (size_t)nxt.pn * tstepB : cB;
        for (int t = 0; t < nt; t += 2) {
            const bool last = (t == nt - 2);
            const char* a1 = cA + (size_t)(t + 1) * kstep;
            const char* a2 = last ? nA : cA + (size_t)(t + 2) * kstep; const char* b2 = last ? nB : cB + (size_t)(t + 2) * kstep;
            const char* a3 = a2 + kstep; const char* b3 = b2 + kstep;
            PG8_LDB(B0, 0, 0); PG8_SCHED; PG8_LDA(At, 0, 0); PG8_STAGE(PG8_SA(1, 1), a1 + hstepA, voffA);
            PG8_WAIT_L(8); PG8_BAR; PG8_WAIT_L(0); PG8_MMA(0, 0, At, B0); PG8_BAR; PG8_SCHED;
            PG8_LDB(B1, 0, 1); PG8_STAGE(PG8_SB(0, 0), b2, voffB);
            PG8_BAR; PG8_WAIT_L(0); PG8_MMA(0, 1, At, B1); PG8_BAR;
            PG8_LDA(At, 0, 1); PG8_STAGE(PG8_SA(0, 0), a2, voffA);
            PG8_BAR; PG8_WAIT_L(0); PG8_MMA(1, 0, At, B0); PG8_BAR; PG8_SCHED;
            PG8_STAGE(PG8_SB(0, 1), b2 + hstepB, voffB);
            PG8_WAIT_V(6); PG8_BAR; PG8_MMA(1, 1, At, B1); PG8_BAR;
            PG8_LDB(B0, 1, 0); PG8_SCHED; PG8_LDA(At, 1, 0); PG8_STAGE(PG8_SA(0, 1), a2 + hstepA, voffA);
            PG8_WAIT_L(8); PG8_BAR; PG8_WAIT_L(0); PG8_MMA(0, 0, At, B0); PG8_BAR; PG8_SCHED;
            PG8_LDB(B1, 1, 1); PG8_STAGE(PG8_SB(1, 0), b3, voffB);
            PG8_BAR; PG8_WAIT_L(0); PG8_MMA(0, 1, At, B1); PG8_BAR;
            PG8_LDA(At, 1, 1); PG8_STAGE(PG8_SA(1, 0), a3, voffA);
            PG8_BAR; PG8_WAIT_L(0); PG8_MMA(1, 0, At, B0); PG8_BAR; PG8_SCHED;
            PG8_STAGE(PG8_SB(1, 1), b3 + hstepB, voffB);
            PG8_WAIT_V(6); PG8_BAR; PG8_MMA(1, 1, At, B1); PG8_BAR;
        }
        E(acc, cur, wr, wc, fr, fq);
        if (!has_next) break;
#pragma unroll
        for (int a = 0; a < 2; ++a)
#pragma unroll
            for (int b = 0; b < 2; ++b)
#pragma unroll
                for (int m = 0; m < 4; ++m)
#pragma unroll
                    for (int n = 0; n < 2; ++n) acc[a][b][m][n] = (f32x4){0.f, 0.f, 0.f, 0.f};
        cur = nxt; cA = nA; cB = nB; ++ui;
    }
    PG8_WAIT_V(0);
    if (wr == 0) PG8_BAR;
    PG8_BAR;
#undef PG8_SA
#undef PG8_SB
#undef PG8_STAGE
#undef PG8_LDA
#undef PG8_LDB
#undef PG8_MMA
#undef PG8_WAIT_V
#undef PG8_WAIT_L
#undef PG8_BAR
#undef PG8_SCHED
}

typedef f32x4 Acc[2][2][4][2];

struct EpiProj {
    static constexpr bool HAS_MID = false;
    bf16_t* O; const float* sumsq;
    __device__ __forceinline__ void operator()(const Acc& acc, const Unit& u, int wr, int wc, int fr, int fq) const {
        const int row0 = u.pm * BM + wr * 64 + fr, col0 = u.pn * BM + wc * 32 + 8 * fq;
        float ssq[2][4];
#pragma unroll
        for (int ai = 0; ai < 2; ++ai)
#pragma unroll
            for (int m = 0; m < 4; ++m) ssq[ai][m] = sumsq[row0 + ai * HALF + m * 16];
        __builtin_amdgcn_sched_barrier(0);
#pragma unroll
        for (int ai = 0; ai < 2; ++ai)
#pragma unroll
            for (int m = 0; m < 4; ++m) {
                const int row = row0 + ai * HALF + m * 16;
                const float rs = rsqrtf(ssq[ai][m] * (1.0f / DM) + EPS);
                bf16_t* rowp = O + (size_t)row * NP + col0;
#pragma unroll
                for (int bj = 0; bj < 2; ++bj) {
                    const f32x4 v0 = acc[ai][bj][m][0] * rs, v1 = acc[ai][bj][m][1] * rs;
                    u32x4 w; w.x = cvt_pk_bf16(v0[0], v0[1]); w.y = cvt_pk_bf16(v0[2], v0[3]); w.z = cvt_pk_bf16(v1[0], v1[1]); w.w = cvt_pk_bf16(v1[2], v1[3]);
                    __builtin_nontemporal_store(w, (u32x4*)(rowp + bj * HALF));
                }
            }
    }
};
#define EPI_SB() __builtin_amdgcn_sched_barrier(0)
template <int SECOND>
struct EpiMix {
    static constexpr bool HAS_MID = false;
    bf16_t* proj;
    template <int AIM> __device__ __forceinline__ void load_q(u32x4 (&wg)[2][2], u32x4 (&wp)[2][2], int row0, int col0) const {
        constexpr int ai = AIM >> 1, m0 = (AIM & 1) * 2;
#pragma unroll
        for (int mm = 0; mm < 2; ++mm) {
            const bf16_t* rowp = proj + (size_t)(row0 + ai * HALF + (m0 + mm) * 16) * NP + col0;
#pragma unroll
            for (int bj = 0; bj < 2; ++bj) {
                wg[mm][bj] = *(const u32x4*)(rowp + (SECOND ? C_GB : C_GA) + bj * HALF);
                if (SECOND) wp[mm][bj] = *(const u32x4*)(rowp + bj * HALF); else wp[mm][bj] = (u32x4){0u, 0u, 0u, 0u};
            }
        }
    }
    template <int AIM> __device__ __forceinline__ void proc_q(const Acc& acc, const u32x4 (&wg)[2][2], const u32x4 (&wp)[2][2], int row0, int col0) const {
        constexpr int ai = AIM >> 1, m0 = (AIM & 1) * 2;
#pragma unroll
        for (int mm = 0; mm < 2; ++mm) {
            bf16_t* rowp = proj + (size_t)(row0 + ai * HALF + (m0 + mm) * 16) * NP + col0;
#pragma unroll
            for (int bj = 0; bj < 2; ++bj) {
                float gt[8], o[8]; unpack8(wg[mm][bj], gt); unpack8(wp[mm][bj], o);
#pragma unroll
                for (int e = 0; e < 8; ++e) o[e] += acc[ai][bj][m0 + mm][e >> 2][e & 3] * sigmoidf_(gt[e]);
                *(u32x4*)(rowp + bj * HALF) = pack8(o);
            }
        }
    }
    __device__ __forceinline__ void operator()(const Acc& acc, const Unit& u, int wr, int wc, int fr, int fq) const {
        const int row0 = u.pm * BM + wr * 64 + fr, col0 = u.pn * BM + wc * 32 + 8 * fq;
        u32x4 g0[2][2], p0[2][2], g1[2][2], p1[2][2];
        load_q<0>(g0, p0, row0, col0); load_q<1>(g1, p1, row0, col0); EPI_SB();
        proc_q<0>(acc, g0, p0, row0, col0); EPI_SB(); load_q<2>(g0, p0, row0, col0); EPI_SB();
        proc_q<1>(acc, g1, p1, row0, col0); EPI_SB(); load_q<3>(g1, p1, row0, col0); EPI_SB();
        proc_q<2>(acc, g0, p0, row0, col0); EPI_SB();
        proc_q<3>(acc, g1, p1, row0, col0); EPI_SB();
    }
};
struct EpiOut {
    static constexpr bool HAS_MID = false;
    int layer; const float* x; const float* meta; float* out; float* hmeta; bf16_t* hb; float* sumsq_next;
    template <int AIM> __device__ __forceinline__ void load_r(f32x4 (&rr)[2][2], int row0, int col0) const {
        constexpr int ai = AIM >> 2, m = AIM & 3;
        const int row = row0 + ai * HALF + m * 16;
        const bool ism = row >= NREAL; const int idx = ism ? row - NREAL : 0;
        const float* rp;
        if (layer == 0) rp = ism ? meta + (size_t)(idx & (NMETA - 1)) * DM : x + (size_t)row * DM;
        else rp = ism ? hmeta + (size_t)idx * DM : out + (size_t)row * DM;
#pragma unroll
        for (int bj = 0; bj < 2; ++bj) { const int c = col0 + bj * HALF; rr[bj][0] = *(const f32x4*)(rp + c); rr[bj][1] = *(const f32x4*)(rp + c + 4); }
    }
    template <int AIM> __device__ __forceinline__ void proc_r(const Acc& acc, const f32x4 (&rr)[2][2], int row0, int col0, int fq) const {
        constexpr int ai = AIM >> 2, m = AIM & 3;
        const int row = row0 + ai * HALF + m * 16;
        const bool ism = row >= NREAL; const int idx = ism ? row - NREAL : 0;
        float* wp = ism ? hmeta + (size_t)idx * DM : out + (size_t)row * DM;
        const bool do_store = (layer == 0) || !ism;
        float ss = 0.f;
#pragma unroll
        for (int bj = 0; bj < 2; ++bj) {
            const int c = col0 + bj * HALF;
            const f32x4 v0 = acc[ai][bj][m][0] + rr[bj][0], v1 = acc[ai][bj][m][1] + rr[bj][1];
            if (do_store) { *(f32x4*)(wp + c) = v0; *(f32x4*)(wp + c + 4) = v1; }
            if (layer == 0) { u32x4 w; w.x = cvt_pk_bf16(v0[0], v0[1]); w.y = cvt_pk_bf16(v0[2], v0[3]); w.z = cvt_pk_bf16(v1[0], v1[1]); w.w = cvt_pk_bf16(v1[2], v1[3]);
                *(u32x4*)(hb + (size_t)row * DM + c) = w; }
            ss += (v0[0] * v0[0] + v0[1] * v0[1]) + (v0[2] * v0[2] + v0[3] * v0[3]) + (v1[0] * v1[0] + v1[1] * v1[1]) + (v1[2] * v1[2] + v1[3] * v1[3]);
        }
        ss += __shfl_xor(ss, 16); ss += __shfl_xor(ss, 32);
        if (fq == 0) atomicAdd(sumsq_next + row, ss);
    }
    __device__ __forceinline__ void operator()(const Acc& acc, const Unit& u, int wr, int wc, int fr, int fq) const {
        const int row0 = u.pm * BM + wr * 64 + fr, col0 = u.pn * BM + wc * 32 + 8 * fq;
        f32x4 r0[2][2], r1[2][2];
        load_r<0>(r0, row0, col0); load_r<1>(r1, row0, col0); EPI_SB();
        proc_r<0>(acc, r0, row0, col0, fq); EPI_SB(); load_r<2>(r0, row0, col0); EPI_SB();
        proc_r<1>(acc, r1, row0, col0, fq); EPI_SB(); load_r<3>(r1, row0, col0); EPI_SB();
        proc_r<2>(acc, r0, row0, col0, fq); EPI_SB(); load_r<4>(r0, row0, col0); EPI_SB();
        proc_r<3>(acc, r1, row0, col0, fq); EPI_SB(); load_r<5>(r1, row0, col0); EPI_SB();
        proc_r<4>(acc, r0, row0, col0, fq); EPI_SB(); load_r<6>(r0, row0, col0); EPI_SB();
        proc_r<5>(acc, r1, row0, col0, fq); EPI_SB(); load_r<7>(r1, row0, col0); EPI_SB();
        proc_r<6>(acc, r0, row0, col0, fq); EPI_SB();
        proc_r<7>(acc, r1, row0, col0, fq); EPI_SB();
    }
};
}

__device__ __forceinline__ void transpose_item(const float* W, int ldw, const float* scale, bf16_t* WT, int ldt, LAS float* scr, int lane) {
    float tv[32];
#pragma unroll
    for (int i = 0; i < 32; ++i) { const int kk = 2 * i + (lane >> 5); tv[i] = W[(size_t)kk * ldw + (lane & 31)]; }
#pragma unroll
    for (int i = 0; i < 32; ++i) { const int kk = 2 * i + (lane >> 5); scr[kk * 33 + (lane & 31)] = tv[i] * (scale ? scale[kk] : 1.0f); }
    LDS_WAIT();
    const int c = lane & 7;
#pragma unroll
    for (int j = 0; j < 4; ++j) { const int n = (lane >> 3) + 8 * j; const LAS float* s = scr + (8 * c) * 33 + n;
        u32x4 o; o.x = cvt_pk_bf16(s[0 * 33], s[1 * 33]); o.y = cvt_pk_bf16(s[2 * 33], s[3 * 33]); o.z = cvt_pk_bf16(s[4 * 33], s[5 * 33]); o.w = cvt_pk_bf16(s[6 * 33], s[7 * 33]);
        *(u32x4*)(WT + (size_t)n * ldt + 8 * c) = o; }
    LDS_WAIT();
}
__device__ __forceinline__ int orig_col(int n) { return n < 1536 ? n : (n < 3072 ? n + 520 : (n < 3584 ? n - 1528 : n + 8)); }

__device__ __forceinline__ void phase0(const Params& p, LAS unsigned char* lds) {
    const int tid = otid(), wave = tid >> 6, lane = tid & 63;
    const int gw = blockIdx.x * 8 + wave, NGW = gridDim.x * 8;
    LAS float* scr = (LAS float*)(lds + wave * 8448);
    bf16_t* W1T = (bf16_t*)(p.ws + OFF_W1T); bf16_t* W23T = (bf16_t*)(p.ws + OFF_W23T); bf16_t* W4T = (bf16_t*)(p.ws + OFF_W4T);
    for (int it = gw; it < 8192; it += NGW) {
        const int l = it >> 12; int r = it & 4095;
        if (r < 3072) { const int kb = r / 192, nb = r % 192, n0 = nb * 32, k0 = kb * 64;
            transpose_item(p.w_in + (size_t)l * DM * WIN + (size_t)k0 * WIN + orig_col(n0), WIN, p.norm_w + l * DM + k0, W1T + (size_t)l * NP * DM + (size_t)n0 * DM + k0, DM, scr, lane);
        } else if (r < 3584) { r -= 3072; const int kb = r / 32, nb = r % 32, n0 = nb * 32, k0 = kb * 64;
            const float* src = kb < 8 ? p.wba + (size_t)l * 512 * DM + (size_t)k0 * DM + n0 : p.wbb + (size_t)l * 512 * DM + (size_t)(k0 - 512) * DM + n0;
            transpose_item(src, DM, nullptr, W23T + (size_t)l * DM * DM + (size_t)n0 * DM + k0, DM, scr, lane);
        } else { r -= 3584; const int kb = r / 32, nb = r % 32, n0 = nb * 32, k0 = kb * 64;
            transpose_item(p.wout + (size_t)l * DM * DM + (size_t)k0 * DM + n0, DM, nullptr, W4T + (size_t)l * DM * DM + (size_t)n0 * DM + k0, DM, scr, lane);
        }
    }
    float* W8 = (float*)(p.ws + OFF_W8);
    for (int i = blockIdx.x * 512 + tid; i < 2 * 8 * DM; i += gridDim.x * 512) { const int l = i >> 13, j = (i >> 10) & 7, k = i & 1023;
        W8[i] = p.norm_w[l * DM + k] * p.w_in[(size_t)l * DM * WIN + (size_t)k * WIN + 1536 + j]; }
    bf16_t* hb = (bf16_t*)(p.ws + OFF_HB); float* sumsq = (float*)(p.ws + OFF_SUMSQ);
    auto row_src = [&](const int row) { return row < NREAL ? p.x + (size_t)row * DM : p.meta + (size_t)((row - NREAL) & (NMETA - 1)) * DM; };
    f32x4 vn[4];
    if (gw < MROWS) { const float* src = row_src(gw);
#pragma unroll
        for (int j = 0; j < 4; ++j) vn[j] = *(const f32x4*)(src + 4 * lane + 256 * j); }
    for (int row = gw; row < MROWS; row += NGW) {
        f32x4 v[4]; float s = 0.f;
#pragma unroll
        for (int j = 0; j < 4; ++j) v[j] = vn[j];
        if (row + NGW < MROWS) { const float* src = row_src(row + NGW);
#pragma unroll
            for (int j = 0; j < 4; ++j) vn[j] = *(const f32x4*)(src + 4 * lane + 256 * j); }
#pragma unroll
        for (int j = 0; j < 4; ++j) s += (v[j][0] * v[j][0] + v[j][1] * v[j][1]) + (v[j][2] * v[j][2] + v[j][3] * v[j][3]);
        s = wave_sum(s);
#pragma unroll
        for (int j = 0; j < 4; ++j) { u32x2 o; o.x = cvt_pk_bf16(v[j][0], v[j][1]); o.y = cvt_pk_bf16(v[j][2], v[j][3]); *(u32x2*)(hb + (size_t)row * DM + 4 * lane + 256 * j) = o; }
        if (lane == 0) { sumsq[row] = s; sumsq[MROWS + row] = 0.f; sumsq[2 * MROWS + row] = 0.f; }
    }
}

__device__ __forceinline__ void bg_pass(const Params& p, int l) {
    const int tid = otid(), wave = tid >> 6, lane = tid & 63;
    const int gw = blockIdx.x * 8 + wave, NGW = gridDim.x * 8;
    const float* W8 = (const float*)(p.ws + OFF_W8) + (size_t)l * 8 * DM;
    const bf16_t* hb = (const bf16_t*)(p.ws + OFF_HB); const float* sumsq = (const float*)(p.ws + OFF_SUMSQ) + (size_t)l * MROWS;
    float* bg = (float*)(p.ws + OFF_BG);
    float wr_[8][16];
#pragma unroll
    for (int j = 0; j < 8; ++j) {
        const f32x4 a0 = *(const f32x4*)(W8 + j * DM + 8 * lane), a1 = *(const f32x4*)(W8 + j * DM + 8 * lane + 4), b0 = *(const f32x4*)(W8 + j * DM + 512 + 8 * lane), b1 = *(const f32x4*)(W8 + j * DM + 512 + 8 * lane + 4);
#pragma unroll
        for (int e = 0; e < 4; ++e) { wr_[j][e] = a0[e]; wr_[j][4 + e] = a1[e]; wr_[j][8 + e] = b0[e]; wr_[j][12 + e] = b1[e]; }
    }
    const int jj = lane & 7, hh = jj & 3;
    const float alog = p.a_log[l * 4 + hh], dtb = p.dt_bias[l * 4 + hh];
    u32x4 n0 = (u32x4){0u, 0u, 0u, 0u}, n1 = n0; float nss = 0.f;
    if (gw < MROWS) { n0 = *(const u32x4*)(hb + (size_t)gw * DM + 8 * lane); n1 = *(const u32x4*)(hb + (size_t)gw * DM + 512 + 8 * lane); nss = sumsq[gw]; }
    for (int row = gw; row < MROWS; row += NGW) {
        const u32x4 w0 = n0, w1 = n1; const float css = nss;
        if (row + NGW < MROWS) { const size_t rn = (size_t)(row + NGW); n0 = *(const u32x4*)(hb + rn * DM + 8 * lane); n1 = *(const u32x4*)(hb + rn * DM + 512 + 8 * lane); nss = sumsq[rn]; }
        float hv[16]; { float t0[8], t1[8]; unpack8(w0, t0); unpack8(w1, t1);
#pragma unroll
            for (int e = 0; e < 8; ++e) { hv[e] = t0[e]; hv[8 + e] = t1[e]; } }
        float d[8];
#pragma unroll
        for (int j = 0; j < 8; ++j) { float s = 0.f;
#pragma unroll
            for (int e = 0; e < 16; ++e) s += hv[e] * wr_[j][e];
            d[j] = wave_sum(s); }
        const float rs = rsqrtf(css * (1.0f / DM) + EPS);
        float val = d[0];
#pragma unroll
        for (int j = 1; j < 8; ++j) val = (jj == j) ? d[j] : val;
        val *= rs;
        const float o = jj < 4 ? sigmoidf_(val) : -__expf(alog) * softplusf_(val + dtb);
        if (lane < 8) bg[(size_t)row * 8 + lane] = o;
    }
}

__device__ __forceinline__ void gdn_prep(const Params& p, int l, LAS unsigned char* lds) {
    const int tid = otid();
    const int tok = tid >> 4, cg8 = (tid & 15) * 8;
    LAS float* sCW = (LAS float*)lds;
    for (int i = tid; i < 4 * 3 * 4 * 128; i += 512) { const int h = i / 1536, rem = i - h * 1536, mat = rem >> 9, tap = (rem >> 7) & 3, c = rem & 127; sCW[i] = p.conv_w[(size_t)l * 4 * 1536 + tap * 1536 + mat * 512 + h * 128 + c]; }
    __syncthreads();
    const bf16_t* proj = (const bf16_t*)(p.ws + OFF_PROJ);
    bf16_t* qk = (bf16_t*)(p.ws + OFF_HB); bf16_t* vb = (bf16_t*)(p.ws + OFF_VB);
    constexpr int NIT = NBATCH * 65 * 4;
    const int G = ogrid();
    auto load_item = [&](const int it, u32x4 (&raw)[3][4]) {
        const int h = it & 3, bc = it >> 2, b = bc / 65, c = bc - b * 65;
        const int t = c * 32 + tok; const bool valid = t < TT;
#pragma unroll
        for (int mat = 0; mat < 3; ++mat)
#pragma unroll
            for (int tap = 0; tap < 4; ++tap) {
                const int ts = t - 3 + tap;
                raw[mat][tap] = (u32x4){0u, 0u, 0u, 0u};
                if (valid && ts >= 0) raw[mat][tap] = *(const u32x4*)(proj + rowof(b, ts) * NP + mat * 512 + h * 128 + cg8);
            }
    };
    auto compute_item = [&](const int it, const u32x4 (&rc)[3][4]) {
        const int h = it & 3, bc = it >> 2, b = bc / 65, c = bc - b * 65;
            const int t = c * 32 + tok; const bool valid = t < TT;
            float cv[3][8];
#pragma unroll
            for (int mat = 0; mat < 3; ++mat) {
#pragma unroll
                for (int e = 0; e < 8; ++e) cv[mat][e] = 0.f;
#pragma unroll
                for (int tap = 0; tap < 4; ++tap) {
                    float xr[8]; unpack8(rc[mat][tap], xr);
                    const f32x4 c0 = *(const LAS f32x4*)(sCW + h * 1536 + (mat * 4 + tap) * 128 + cg8), c1 = *(const LAS f32x4*)(sCW + h * 1536 + (mat * 4 + tap) * 128 + cg8 + 4);
#pragma unroll
                    for (int e = 0; e < 4; ++e) { cv[mat][e] += c0[e] * xr[e]; cv[mat][4 + e] += c1[e] * xr[4 + e]; }
                }
#pragma unroll
                for (int e = 0; e < 8; ++e) cv[mat][e] = siluf_(cv[mat][e]);
            }
            float sq = 0.f, sk = 0.f;
#pragma unroll
            for (int e = 0; e < 8; ++e) { sq += cv[0][e] * cv[0][e]; sk += cv[1][e] * cv[1][e]; }
#pragma unroll
            for (int o = 1; o < 16; o <<= 1) { sq += __shfl_xor(sq, o); sk += __shfl_xor(sk, o); }
            const float rq = rsqrtf(sq + EPS) * 0.08838834764831845f, rk = rsqrtf(sk + EPS);
#pragma unroll
            for (int e = 0; e < 8; ++e) { cv[0][e] *= rq; cv[1][e] *= rk; }
            if (valid) {
                const size_t row = rowof(b, t);
                *(u32x4*)(qk + row * DM + h * 128 + cg8) = pack8(cv[0]);
                *(u32x4*)(qk + row * DM + 512 + h * 128 + cg8) = pack8(cv[1]);
                *(u32x4*)(vb + row * 512 + h * 128 + cg8) = pack8(cv[2]);
            }
    };
    u32x4 r0[3][4], r1[3][4], r2[3][4];
    int it = obid();
    if (it < NIT) load_item(it, r0);
    if (it + G < NIT) load_item(it + G, r1);
    while (it < NIT) {
        if (it + 2 * G < NIT) load_item(it + 2 * G, r2);
        compute_item(it, r0); it += G; if (it >= NIT) break;
        if (it + 2 * G < NIT) load_item(it + 2 * G, r0);
        compute_item(it, r1); it += G; if (it >= NIT) break;
        if (it + 2 * G < NIT) load_item(it + 2 * G, r1);
        compute_item(it, r2); it += G;
    }
}

__device__ __forceinline__ void gdn_chain(const Params& p, int l, int b, int h, LAS unsigned char* lds, bool dummy = false) {
    const int tid = otid(), wave = tid >> 6, lane = tid & 63, r = lane & 15, q = lane >> 4;
    const int tok = tid >> 4, cg8 = (tid & 15) * 8;
    LAS bf16_t* sQ = (LAS bf16_t*)(lds + 0);
    LAS bf16_t* sK = (LAS bf16_t*)(lds + 8704);
    LAS bf16_t* sKb = (LAS bf16_t*)(lds + 17408);
    LAS bf16_t* sV = (LAS bf16_t*)(lds + 26112);
    LAS bf16_t* sVT = (LAS bf16_t*)(lds + 36352);
    LAS bf16_t* sVTs = (LAS bf16_t*)(lds + 46592);
    LAS bf16_t* sTb = (LAS bf16_t*)(lds + 56832);
    LAS bf16_t* sP = (LAS bf16_t*)(lds + 59392);
    LAS bf16_t* sSt = (LAS bf16_t*)(lds + 61952);
    LAS float* sAm = (LAS float*)(lds + 96768);
    LAS float* sO = (LAS float*)(lds + 101376);
    LAS float* sG = (LAS float*)(lds + 118272);
    LAS float* sCW = (LAS float*)(lds + 118400);
    LAS bf16_t* sA21 = (LAS bf16_t*)(lds + 124544);
    LAS bf16_t* sT11T = (LAS bf16_t*)(lds + 125824);
    LAS bf16_t* sT22 = (LAS bf16_t*)(lds + 127104);
    LAS bf16_t* sXT = (LAS bf16_t*)(lds + 128384);
    LAS bf16_t* sTbg = (LAS bf16_t*)(lds + 129664);
    LAS float* sBeta = (LAS float*)(lds + 132224);
    LAS float* sEgl = (LAS float*)(lds + 132352);
    bf16_t* proj = (bf16_t*)(p.ws + OFF_PROJ);
    const float* bg = (const float*)(p.ws + OFF_BG);
    for (int i = tid; i < 128 * 136 / 2; i += 512) ((LAS unsigned*)sSt)[i] = 0u;
    for (int i = tid; i < 4 * 16 * 40 / 2; i += 512) ((LAS unsigned*)sA21)[i] = 0u;
    for (int i = tid; i < 32 * 40 / 2; i += 512) { ((LAS unsigned*)sTb)[i] = 0u; ((LAS unsigned*)sTbg)[i] = 0u; }
    f32x4 Sacc[8];
#pragma unroll
    for (int i = 0; i < 8; ++i) Sacc[i] = (f32x4){0.f, 0.f, 0.f, 0.f};
    float gn[8];
#pragma unroll
    for (int e = 0; e < 8; ++e) gn[e] = p.gnorm_a[l * 128 + cg8 + e];
    __syncthreads();
    const size_t rowbase = (size_t)b * TT;
    const int tr = wave >> 2, vc0 = (wave & 3) * 2;
    const bf16_t* qkb = (const bf16_t*)(p.ws + OFF_HB); const bf16_t* vbb = (const bf16_t*)(p.ws + OFF_VB);
    u32x4 pq, pk, pv;
    { const size_t row = rowof(b, tok); pq = *(const u32x4*)(qkb + row * DM + h * 128 + cg8); pk = *(const u32x4*)(qkb + row * DM + 512 + h * 128 + cg8); pv = *(const u32x4*)(vbb + row * 512 + h * 128 + cg8); }
    float pgj = bg[rowof(b, (lane & 31)) * 8 + 4 + h], pbeta = bg[rowof(b, tok) * 8 + h];
    for (int c = 0; c < 65; ++c) {
        const int t0 = c * 32, t = t0 + tok; const bool valid = t < TT;
        float gj = pgj; const float beta = pbeta;
        { const int tj = t0 + 32 + (lane & 31), tn = t + 32; pgj = (tj < TT) ? bg[rowof(b, tj) * 8 + 4 + h] : 0.f; pbeta = (tn < TT) ? bg[rowof(b, tn) * 8 + h] : 0.f; }
#pragma unroll
        for (int d = 1; d < 32; d <<= 1) { const float tt = __shfl_up(gj, d, 32); if ((lane & 31) >= d) gj += tt; }
        const float Gt = __shfl(gj, tok, 64), glast = __shfl(gj, 31, 64);
        if (wave == 0 && lane < 32) sG[lane] = gj;
        bf16_t* const zp = proj + rowof(b, (valid ? t : 0)) * NP + C_AZ + h * 128 + cg8;
        const u32x4 zreg = *(const u32x4*)zp;
        {
            const u32x4 cq = pq, ck = pk, cvv = pv;
            const int tn = t + 32;
            pq = (u32x4){0u, 0u, 0u, 0u}; pk = pq; pv = pq;
            if (tn < TT) { const size_t row = rowof(b, tn); pq = *(const u32x4*)(qkb + row * DM + h * 128 + cg8); pk = *(const u32x4*)(qkb + row * DM + 512 + h * 128 + cg8); pv = *(const u32x4*)(vbb + row * 512 + h * 128 + cg8); }
            const float eGl = __expf(glast - Gt);
            *(LAS u32x4*)(sQ + tok * 136 + cg8) = cq;
            *(LAS u32x4*)(sK + tok * 136 + cg8) = ck;
            *(LAS u32x4*)(sV + tok * 136 + cg8) = cvv;
            if ((tid & 15) == 0) { sBeta[tok] = beta; sEgl[tok] = eGl; }
        }
        BAR_LDS();
        {
            const int w4 = wave & 3, ti = w4 >> 1, tj = w4 & 1;
            f32x4 a = (f32x4){0.f, 0.f, 0.f, 0.f};
            a = mma_tile<128>(a, (wave < 4 ? sK : sQ) + ti * 16 * 136, 136, sK + tj * 16 * 136, 136, r, q);
            const int jcol = tj * 16 + r; const float Gj = sG[jcol];
#pragma unroll
            for (int j = 0; j < 4; ++j) {
                const int i = ti * 16 + q * 4 + j; const float Gi = sG[i];
                const float dec = __expf(fminf(Gi - Gj, 0.f));
                if (wave < 4) { const float ab = a[j] * dec * sBeta[i]; sAm[jcol * 36 + i] = (i > jcol) ? ab : 0.f; if (w4 == 2) sA21[(i - 16) * 40 + jcol] = f2bf(ab); }
                else sP[i * 40 + jcol] = f2bf((i >= jcol) ? a[j] * dec : 0.f);
            }
        }
        BAR_LDS();
        if (wave == 0) {
            if (lane < 32) {
                const int blk = lane >> 4, cc = lane & 15;
                const LAS float* Ab = sAm + (16 * blk) * 36 + 16 * blk;
                const float bj = sBeta[16 * blk + cc], bgj = bj * __expf(sG[16 * blk + cc]);
                float xx[16];
#pragma unroll
                for (int i = 0; i < 16; ++i) xx[i] = (i == cc) ? 1.f : 0.f;
                f32x4 ar[2][4];
#pragma unroll
                for (int g = 0; g < 4; ++g) ar[0][g] = *(const volatile LAS f32x4*)(Ab + g * 4);
#pragma unroll
                for (int j = 0; j < 15; ++j) {
                    if (j + 1 < 15) {
#pragma unroll
                        for (int g = (j + 2) / 4; g < 4; ++g) ar[(j + 1) & 1][g] = *(const volatile LAS f32x4*)(Ab + (j + 1) * 36 + g * 4);
                    }
#pragma unroll
                    for (int i = j + 1; i < 16; ++i) xx[i] -= ar[j & 1][i >> 2][i & 3] * xx[j];
                }
#pragma unroll
                for (int i = 0; i < 16; ++i) { sTb[(16 * blk + i) * 40 + 16 * blk + cc] = f2bf(xx[i] * bj); sTbg[(16 * blk + i) * 40 + 16 * blk + cc] = f2bf(xx[i] * bgj); }
                if (blk == 0) {
                    float lo[8], hi[8];
#pragma unroll
                    for (int i = 0; i < 8; ++i) { lo[i] = xx[i]; hi[i] = xx[8 + i]; }
                    *(LAS u32x4*)(sT11T + cc * 40) = pack8(lo); *(LAS u32x4*)(sT11T + cc * 40 + 8) = pack8(hi);
                } else {
#pragma unroll
                    for (int i = 0; i < 16; ++i) sT22[i * 40 + cc] = f2bf(xx[i]);
                }
            }
            LDS_WAIT();
            const f32x4 X = mma_tile<32>((f32x4){0.f, 0.f, 0.f, 0.f}, sA21, 40, sT11T, 40, r, q);
            { u32x2 w; w.x = cvt_pk_bf16(X[0], X[1]); w.y = cvt_pk_bf16(X[2], X[3]); *(LAS u32x2*)(sXT + r * 40 + q * 4) = w; }
            LDS_WAIT();
            const f32x4 Y = mma_tile<32>((f32x4){0.f, 0.f, 0.f, 0.f}, sT22, 40, sXT, 40, r, q);
#pragma unroll
            for (int j = 0; j < 4; ++j) { const float bj = sBeta[r], bgj = bj * __expf(sG[r]); sTb[(16 + q * 4 + j) * 40 + r] = f2bf(-Y[j] * bj); sTbg[(16 + q * 4 + j) * 40 + r] = f2bf(-Y[j] * bgj); }
        }
        BAR_LDS();
        f32x4 au[2], ao[2];
        {
            const bf16x8 aTb = *(const LAS bf16x8*)(sTb + (tr * 16 + r) * 40 + q * 8), aTbg = *(const LAS bf16x8*)(sTbg + (tr * 16 + r) * 40 + q * 8);
#pragma unroll
            for (int x = 0; x < 2; ++x) {
                const int vc = vc0 + x;
                au[x] = __builtin_amdgcn_mfma_f32_16x16x32_bf16(aTb, frag_tr(sV, 136, 0, vc * 16, lane), (f32x4){0.f, 0.f, 0.f, 0.f}, 0, 0, 0);
                const f32x4 aw = __builtin_amdgcn_mfma_f32_16x16x32_bf16(aTbg, frag_tr(sK, 136, 0, vc * 16, lane), (f32x4){0.f, 0.f, 0.f, 0.f}, 0, 0, 0);
#pragma unroll
                for (int j = 0; j < 4; ++j) sKb[(tr * 16 + q * 4 + j) * 136 + vc * 16 + r] = f2bf(-aw[j]);
            }
        }
        BAR_LDS();
        {
            bf16x8 aW[4], aQ[4];
#pragma unroll
            for (int kk = 0; kk < 4; ++kk) { aW[kk] = *(const LAS bf16x8*)(sKb + (tr * 16 + r) * 136 + kk * 32 + q * 8); aQ[kk] = *(const LAS bf16x8*)(sQ + (tr * 16 + r) * 136 + kk * 32 + q * 8); }
            const f32x4 gi = *(const LAS f32x4*)(sG + tr * 16 + q * 4);
            const f32x4 eg = *(const LAS f32x4*)(sEgl + tr * 16 + q * 4);
#pragma unroll
            for (int x = 0; x < 2; ++x) {
                const int vc = vc0 + x;
                ao[x] = (f32x4){0.f, 0.f, 0.f, 0.f};
#pragma unroll
                for (int kk = 0; kk < 4; ++kk) {
                    const bf16x8 bS = *(const LAS bf16x8*)(sSt + (vc * 16 + r) * 136 + kk * 32 + q * 8);
                    au[x] = __builtin_amdgcn_mfma_f32_16x16x32_bf16(aW[kk], bS, au[x], 0, 0, 0);
                    ao[x] = __builtin_amdgcn_mfma_f32_16x16x32_bf16(aQ[kk], bS, ao[x], 0, 0, 0);
                }
#pragma unroll
                for (int j = 0; j < 4; ++j) ao[x][j] *= __expf(gi[j]);
                u32x2 w; w.x = cvt_pk_bf16(au[x][0], au[x][1]); w.y = cvt_pk_bf16(au[x][2], au[x][3]);
                *(LAS u32x2*)(sVT + (vc * 16 + r) * 40 + tr * 16 + q * 4) = w;
                u32x2 ws; ws.x = cvt_pk_bf16(au[x][0] * eg[0], au[x][1] * eg[1]); ws.y = cvt_pk_bf16(au[x][2] * eg[2], au[x][3] * eg[3]);
                *(LAS u32x2*)(sVTs + (vc * 16 + r) * 40 + tr * 16 + q * 4) = ws;
            }
        }
        BAR_LDS();
        {
            const bf16x8 aP = *(const LAS bf16x8*)(sP + (tr * 16 + r) * 40 + q * 8);
#pragma unroll
            for (int x = 0; x < 2; ++x) {
                const int vc = vc0 + x;
                const bf16x8 bV = *(const LAS bf16x8*)(sVT + (vc * 16 + r) * 40 + q * 8);
                ao[x] = __builtin_amdgcn_mfma_f32_16x16x32_bf16(aP, bV, ao[x], 0, 0, 0);
#pragma unroll
                for (int j = 0; j < 4; ++j) sO[(tr * 16 + q * 4 + j) * 132 + vc * 16 + r] = ao[x][j];
            }
        }
        {
            const float egl = __expf(glast);
            const bf16x8 bVs = *(const LAS bf16x8*)(sVTs + (wave * 16 + r) * 40 + q * 8);
            bf16x8 aK[8];
#pragma unroll
            for (int kr = 0; kr < 8; ++kr) aK[kr] = frag_tr(sK, 136, 0, kr * 16, lane);
#pragma unroll
            for (int kr = 0; kr < 8; ++kr) {
                Sacc[kr] = Sacc[kr] * egl;
                Sacc[kr] = __builtin_amdgcn_mfma_f32_16x16x32_bf16(aK[kr], bVs, Sacc[kr], 0, 0, 0);
                u32x2 w; w.x = cvt_pk_bf16(Sacc[kr][0], Sacc[kr][1]); w.y = cvt_pk_bf16(Sacc[kr][2], Sacc[kr][3]);
                *(LAS u32x2*)(sSt + (wave * 16 + r) * 136 + kr * 16 + q * 4) = w;
            }
        }
        BAR_LDS();
        {
            const f32x4 o0 = *(const LAS f32x4*)(sO + tok * 132 + cg8), o1 = *(const LAS f32x4*)(sO + tok * 132 + cg8 + 4);
            float ss = (o0[0] * o0[0] + o0[1] * o0[1]) + (o0[2] * o0[2] + o0[3] * o0[3]) + (o1[0] * o1[0] + o1[1] * o1[1]) + (o1[2] * o1[2] + o1[3] * o1[3]);
#pragma unroll
            for (int o = 1; o < 16; o <<= 1) ss += __shfl_xor(ss, o);
            const float rs = rsqrtf(ss * (1.0f / 128.0f) + EPS);
            if (valid) {
                float z[8], y[8]; unpack8(zreg, z);
#pragma unroll
                for (int e = 0; e < 4; ++e) { y[e] = o0[e] * rs * gn[e] * siluf_(z[e]); y[4 + e] = o1[e] * rs * gn[4 + e] * siluf_(z[4 + e]); }
                __builtin_nontemporal_store(pack8(y), (u32x4*)(dummy ? (bf16_t*)(p.ws + OFF_HB) + rowof(b, t) * DM + h * 128 + cg8 : zp));
            }
        }
    }
    __syncthreads();
}

__device__ __forceinline__ void hgrn_chain(const Params& p, int l, int b, int h, LAS unsigned char* lds, bool dummy = false) {
    const int tid = otid(), wave = tid >> 6, lane = tid & 63, r = lane & 15, q = lane >> 4;
    const int tok = tid >> 4, cg8 = (tid & 15) * 8;
    LAS bf16_t* sQ = (LAS bf16_t*)(lds + 0);
    LAS bf16_t* sKh = (LAS bf16_t*)(lds + 8704);
    LAS bf16_t* sV = (LAS bf16_t*)(lds + 17408);
    LAS bf16_t* sKt = (LAS bf16_t*)(lds + 27648);
    LAS bf16_t* sSc = (LAS bf16_t*)(lds + 37888);
    LAS bf16_t* sSt = (LAS bf16_t*)(lds + 40448);
    LAS float* sF = (LAS float*)(lds + 75264);
    LAS float* sO = (LAS float*)(lds + 91648);
    LAS float* sEbl = (LAS float*)(lds + 108544);
    bf16_t* proj = (bf16_t*)(p.ws + OFF_PROJ);
    for (int i = tid; i < 128 * 136 / 2; i += 512) ((LAS unsigned*)sSt)[i] = 0u;
    f32x4 Sacc[8];
#pragma unroll
    for (int i = 0; i < 8; ++i) Sacc[i] = (f32x4){0.f, 0.f, 0.f, 0.f};
    float gn[8], lbv[8];
#pragma unroll
    for (int e = 0; e < 8; ++e) {
        gn[e] = p.gnorm_b[l * 128 + cg8 + e];
        const float x0 = p.lbraw[h * 128 + cg8 + e], x1 = p.lbraw[512 + h * 128 + cg8 + e], mx = fmaxf(x0, x1);
        const float e0 = __expf(x0 - mx), e1 = __expf(x1 - mx), s0 = e0 / (e0 + e1), s1 = e1 / (e0 + e1);
        lbv[e] = (l == 0) ? 0.f : ((s0 + s1) - s0);
    }
    __syncthreads();
    const size_t rowbase = (size_t)b * TT;
    const int tr = wave >> 2, vc0 = (wave & 3) * 2;
    u32x4 pq, pf, pi, pz;
    { const bf16_t* rn = proj + rowof(b, tok) * NP + h * 128 + cg8; pq = *(const u32x4*)(rn + C_BQ); pf = *(const u32x4*)(rn + C_BF); pi = *(const u32x4*)(rn + C_BI); pz = *(const u32x4*)(rn + C_BG); }
    for (int c = 0; c < 65; ++c) {
        const int t0 = c * 32, t = t0 + tok; const bool valid = t < TT;
        float qv[8], kk[8], vv[8], lf[8];
        const u32x4 cq = pq, cf = pf, ci = pi, cz = pz;
        { const int tn = t + 32; if (tn < TT) { const bf16_t* rn = proj + rowof(b, tn) * NP + h * 128 + cg8;
            pq = *(const u32x4*)(rn + C_BQ); pf = *(const u32x4*)(rn + C_BF); pi = *(const u32x4*)(rn + C_BI); pz = *(const u32x4*)(rn + C_BG); } }
        if (valid) {
            float zq[8], zf[8]; unpack8(cq, zq); unpack8(cf, zf); unpack8(ci, vv);
#pragma unroll
            for (int e = 0; e < 8; ++e) {
                qv[e] = siluf_(zq[e]) * 0.08838834764831845f;
                const float z = zf[e];
                const float en = __expf(-fabsf(z));
                const float rden = __builtin_amdgcn_rcpf(1.0f + en);
                const float logsig = fminf(z, 0.f) - __logf(1.0f + en);
                const float sig = (z >= 0.f ? 1.0f : en) * rden;
                const float nsig = (z >= 0.f ? en : 1.0f) * rden;
                const float lb = lbv[e];
                if (lb > 0.f) { lf[e] = __logf(lb + (1.0f - lb) * sig); kk[e] = (1.0f - lb) * nsig; }
                else { lf[e] = logsig; kk[e] = nsig; }
            }
        } else {
#pragma unroll
            for (int e = 0; e < 8; ++e) { qv[e] = 0.f; kk[e] = 0.f; vv[e] = 0.f; lf[e] = 0.f; }
        }
        *(LAS f32x4*)(sF + tok * 128 + cg8) = (f32x4){lf[0], lf[1], lf[2], lf[3]};
        *(LAS f32x4*)(sF + tok * 128 + cg8 + 4) = (f32x4){lf[4], lf[5], lf[6], lf[7]};
        BAR_LDS();
        if (tid < 128) { float cs[32];
#pragma unroll
            for (int i = 0; i < 32; ++i) cs[i] = sF[i * 128 + tid];
#pragma unroll
            for (int i = 1; i < 32; ++i) cs[i] += cs[i - 1];
#pragma unroll
            for (int i = 0; i < 32; ++i) sF[i * 128 + tid] = cs[i];
            sEbl[tid] = __expf(cs[31]); }
        BAR_LDS();
        {
            const f32x4 b0 = *(const LAS f32x4*)(sF + tok * 128 + cg8), b1 = *(const LAS f32x4*)(sF + tok * 128 + cg8 + 4);
            const f32x4 l0 = *(const LAS f32x4*)(sEbl + cg8), l1 = *(const LAS f32x4*)(sEbl + cg8 + 4);
            float qt[8], kh[8], kt[8];
#pragma unroll
            for (int e = 0; e < 8; ++e) {
                const float bc = e < 4 ? b0[e & 3] : b1[e & 3], ebl = e < 4 ? l0[e & 3] : l1[e & 3];
                const float ebc = __expf(bc);
                qt[e] = qv[e] * ebc; kh[e] = kk[e] * __builtin_amdgcn_rcpf(ebc);
                kt[e] = kh[e] * ebl;
            }
            *(LAS u32x4*)(sKt + tok * 136 + cg8) = pack8(kt);
            *(LAS u32x4*)(sV + tok * 136 + cg8) = pack8(vv);
            *(LAS u32x4*)(sQ + tok * 136 + cg8) = pack8(qt);
            *(LAS u32x4*)(sKh + tok * 136 + cg8) = pack8(kh);
        }
        BAR_LDS();
        if (wave < 4) {
            const int ti = wave >> 1, tj = wave & 1;
            const f32x4 a = mma_tile<128>((f32x4){0.f, 0.f, 0.f, 0.f}, sQ + ti * 16 * 136, 136, sKh + tj * 16 * 136, 136, r, q);
            const int jcol = tj * 16 + r;
#pragma unroll
            for (int j = 0; j < 4; ++j) { const int i = ti * 16 + q * 4 + j; sSc[i * 40 + jcol] = f2bf((i >= jcol) ? a[j] : 0.f); }
        }
        f32x4 ao[2];
        {
            bf16x8 aQ[4];
#pragma unroll
            for (int kk = 0; kk < 4; ++kk) aQ[kk] = *(const LAS bf16x8*)(sQ + (tr * 16 + r) * 136 + kk * 32 + q * 8);
#pragma unroll
            for (int x = 0; x < 2; ++x) {
                ao[x] = (f32x4){0.f, 0.f, 0.f, 0.f};
#pragma unroll
                for (int kk = 0; kk < 4; ++kk) ao[x] = __builtin_amdgcn_mfma_f32_16x16x32_bf16(aQ[kk], *(const LAS bf16x8*)(sSt + ((vc0 + x) * 16 + r) * 136 + kk * 32 + q * 8), ao[x], 0, 0, 0);
            }
        }
        BAR_LDS();
        {
            const bf16x8 aSc = *(const LAS bf16x8*)(sSc + (tr * 16 + r) * 40 + q * 8);
#pragma unroll
            for (int x = 0; x < 2; ++x) {
                const int vc = vc0 + x;
                ao[x] = __builtin_amdgcn_mfma_f32_16x16x32_bf16(aSc, frag_tr(sV, 136, 0, vc * 16, lane), ao[x], 0, 0, 0);
#pragma unroll
                for (int j = 0; j < 4; ++j) sO[(tr * 16 + q * 4 + j) * 132 + vc * 16 + r] = ao[x][j];
            }
        }
        {
            const bf16x8 bV = frag_tr(sV, 136, 0, wave * 16, lane);
            bf16x8 aK[8];
#pragma unroll
            for (int kr = 0; kr < 8; ++kr) aK[kr] = frag_tr(sKt, 136, 0, kr * 16, lane);
#pragma unroll
            for (int kr = 0; kr < 8; ++kr) {
                const f32x4 ebl = *(const LAS f32x4*)(sEbl + kr * 16 + q * 4);
                Sacc[kr] = Sacc[kr] * ebl;
                Sacc[kr] = __builtin_amdgcn_mfma_f32_16x16x32_bf16(aK[kr], bV, Sacc[kr], 0, 0, 0);
                u32x2 w; w.x = cvt_pk_bf16(Sacc[kr][0], Sacc[kr][1]); w.y = cvt_pk_bf16(Sacc[kr][2], Sacc[kr][3]);
                *(LAS u32x2*)(sSt + (wave * 16 + r) * 136 + kr * 16 + q * 4) = w;
            }
        }
        BAR_LDS();
        {
            const f32x4 o0 = *(const LAS f32x4*)(sO + tok * 132 + cg8), o1 = *(const LAS f32x4*)(sO + tok * 132 + cg8 + 4);
            float ss = (o0[0] * o0[0] + o0[1] * o0[1]) + (o0[2] * o0[2] + o0[3] * o0[3]) + (o1[0] * o1[0] + o1[1] * o1[1]) + (o1[2] * o1[2] + o1[3] * o1[3]);
#pragma unroll
            for (int o = 1; o < 16; o <<= 1) ss += __shfl_xor(ss, o);
            const float rs = rsqrtf(ss * (1.0f / 128.0f) + EPS);
            if (valid) {
                bf16_t* zp = proj + rowof(b, t) * NP + C_BG + h * 128 + cg8;
                float z[8], y[8]; unpack8(cz, z);
#pragma unroll
                for (int e = 0; e < 4; ++e) { y[e] = o0[e] * rs * gn[e] * siluf_(z[e]); y[4 + e] = o1[e] * rs * gn[4 + e] * siluf_(z[4 + e]); }
                __builtin_nontemporal_store(pack8(y), (u32x4*)(dummy ? (bf16_t*)(p.ws + OFF_HB) + rowof(b, t) * DM + 512 + h * 128 + cg8 : zp));
            }
        }
    }
    __syncthreads();
}

__device__ __forceinline__ void final_phase(const Params& p) {
    const int tid = otid(), wave = tid >> 6, lane = tid & 63;
    const int gw = blockIdx.x * 8 + wave, NGW = gridDim.x * 8;
    const float* sumsq = (const float*)(p.ws + OFF_SUMSQ) + (size_t)2 * MROWS;
    f32x4 w[4];
#pragma unroll
    for (int j = 0; j < 4; ++j) w[j] = *(const f32x4*)(p.fnw + 4 * lane + 256 * j);
    f32x4 vn[4]; float nss = 0.f;
    if (gw < NBATCH * SEQ) { nss = sumsq[gw];
#pragma unroll
        for (int j = 0; j < 4; ++j) vn[j] = *(const f32x4*)(p.out + (size_t)gw * DM + 4 * lane + 256 * j); }
    for (int rr = gw; rr < NBATCH * SEQ; rr += NGW) {
        f32x4 v[4]; const float css = nss;
#pragma unroll
        for (int j = 0; j < 4; ++j) v[j] = vn[j];
        if (rr + NGW < NBATCH * SEQ) { const size_t rn = (size_t)(rr + NGW); nss = sumsq[rn];
#pragma unroll
            for (int j = 0; j < 4; ++j) vn[j] = *(const f32x4*)(p.out + rn * DM + 4 * lane + 256 * j); }
        const float rs = rsqrtf(css * (1.0f / DM) + EPS);
        float* op = p.out + (size_t)rr * DM + 4 * lane;
#pragma unroll
        for (int j = 0; j < 4; ++j) *(f32x4*)(op + 256 * j) = v[j] * rs * w[j];
    }
}

template <int K>
__device__ __forceinline__ void run_phase(const Params& p, int l, LAS unsigned char* lds) {
    bf16_t* proj = (bf16_t*)(p.ws + OFF_PROJ); bf16_t* hb = (bf16_t*)(p.ws + OFF_HB);
    float* sumsq = (float*)(p.ws + OFF_SUMSQ);
    if constexpr (K == 0) phase0(p, lds);
    else if constexpr (K == 1) {
        bg_pass(p, l);
        pg8::Gemm g{hb, (const bf16_t*)(p.ws + OFF_W1T) + (size_t)l * NP * DM, MROWS, NP, DM, DM, DM};
        pg8::StaticOrder S; S.init(g.M, g.N, (int)gridDim.x, (int)blockIdx.x);
        pg8::EpiProj E{proj, sumsq + (size_t)l * MROWS};
        pg8::gemm_phase(lds, g, S, E);
    } else if constexpr (K == 6) {
        gdn_prep(p, l, lds);
    } else if constexpr (K == 2) {
        for (int ch = blockIdx.x; ch < 256; ch += gridDim.x) {
            if (ch < 128) gdn_chain(p, l, ch >> 2, ch & 3, lds);
            else hgrn_chain(p, l, (ch - 128) >> 2, ch & 3, lds);
        }
    } else if constexpr (K == 3) {
        const bf16_t* W23 = (const bf16_t*)(p.ws + OFF_W23T) + (size_t)l * DM * DM;
        const int Mrows = l == 1 ? NREAL : MROWS;
        pg8::StaticOrder S; S.init(Mrows, DM, (int)gridDim.x, (int)blockIdx.x);
        { pg8::Gemm g{proj + C_AZ, W23, Mrows, DM, 512, NP, DM}; pg8::EpiMix<0> E{proj}; pg8::gemm_phase(lds, g, S, E); }
        __builtin_amdgcn_fence(__ATOMIC_SEQ_CST, "workgroup");
        { pg8::Gemm g{proj + C_BG, W23 + 512, Mrows, DM, 512, NP, DM}; pg8::EpiMix<1> E{proj}; pg8::gemm_phase(lds, g, S, E); }
    } else if constexpr (K == 4) {
        pg8::Gemm g{proj, (const bf16_t*)(p.ws + OFF_W4T) + (size_t)l * DM * DM, l == 1 ? NREAL : MROWS, DM, DM, NP, DM};
        pg8::StaticOrder S; S.init(g.M, g.N, (int)gridDim.x, (int)blockIdx.x);
        pg8::EpiOut E{l, p.x, p.meta, p.out, (float*)(p.ws + OFF_HMETA), hb, sumsq + (size_t)(l + 1) * MROWS};
        pg8::gemm_phase(lds, g, S, E);
    } else final_phase(p);
}

#define XB_TMO      128
#define XB_XCNT(j)  (256  + 64 * (j))
#define XB_XSUB(j)  (1280 + 64 * (j))
#define XB_XGEN(j)  (2304 + 64 * (j))
#define XB_TOP      3328
#define XB_TOPGEN   3392
#define XCD_BAR_WORDS 3456
#define XB_SPIN_CAP (1u << 18)
__device__ __forceinline__ unsigned xb_ld(unsigned* p)              { return __hip_atomic_load(p, __ATOMIC_RELAXED, __HIP_MEMORY_SCOPE_AGENT); }
__device__ __forceinline__ unsigned xb_add(unsigned* p, unsigned v) { return __hip_atomic_fetch_add(p, v, __ATOMIC_RELAXED, __HIP_MEMORY_SCOPE_AGENT); }
__device__ __forceinline__ unsigned xb_xcc_id() { return (unsigned)__builtin_amdgcn_s_getreg((3 << 11) | 20) & 0xFu; }
#define XB_SPIN(cond, bar) do { unsigned _sp = 0; while (cond) { __builtin_amdgcn_s_sleep(1); \
    if ((++_sp & 255u) == 0u) { if (xb_ld(&(bar)[XB_TMO])) break; if (_sp > XB_SPIN_CAP) { atomicAdd(&(bar)[XB_TMO], 1u); break; } } } } while (0)
struct XcdBarrier { unsigned* bar; unsigned x; volatile LAS unsigned* st; };
__device__ __forceinline__ XcdBarrier xcd_barrier_post(unsigned* bar, volatile LAS unsigned* st) {
    XcdBarrier b; b.bar = bar; b.x = xb_xcc_id(); b.st = st;
    if (threadIdx.x == 0) (void)xb_add(&bar[XB_XCNT(b.x)], 1u);
    return b;
}
__device__ __forceinline__ void xcd_barrier_complete(unsigned* bar, unsigned x, unsigned& nloc, unsigned& nx) {
    const unsigned G = gridDim.x * gridDim.y * gridDim.z;
    unsigned sum, cnt, mine, sp = 0u;
    for (;;) {
        sum = 0u; cnt = 0u; mine = 0u;
#pragma unroll
        for (unsigned j = 0; j < 16; ++j) { const unsigned c = xb_ld(&bar[XB_XCNT(j)]); sum += c; cnt += (c > 0u) ? 1u : 0u; mine = (j == x) ? c : mine; }
        if (sum == G) break;
        __builtin_amdgcn_s_sleep(1);
        if ((++sp & 255u) == 0u) { if (xb_ld(&bar[XB_TMO])) break; if (sp > XB_SPIN_CAP) { atomicAdd(&bar[XB_TMO], 1u); break; } }
    }
    nloc = mine > 0u ? mine : 1u; nx = cnt > 0u ? cnt : 1u;
}
__device__ __forceinline__ void xcd_barrier(const XcdBarrier& b) {
    asm volatile("s_waitcnt vmcnt(0)" ::: "memory");
    __syncthreads();
    if (threadIdx.x == 0) {
        unsigned* bar = b.bar;
        __builtin_amdgcn_s_waitcnt(0);
        unsigned nloc = b.st[0], nx = b.st[1];
        if (nloc == 0u) { xcd_barrier_complete(bar, b.x, nloc, nx); b.st[0] = nloc; b.st[1] = nx; }
        const unsigned old = xb_add(&bar[XB_XSUB(b.x)], 1u);
        const unsigned gen = old / nloc;
        if (old + 1u == (gen + 1u) * nloc) {
            __builtin_amdgcn_fence(__ATOMIC_RELEASE, "agent");
            asm volatile("s_waitcnt vmcnt(0)" ::: "memory");
            const unsigned og = xb_add(&bar[XB_TOP], 1u);
            const unsigned tg = og / nx;
            if (og + 1u == (tg + 1u) * nx) xb_add(&bar[XB_TOPGEN], 1u);
            else XB_SPIN(xb_ld(&bar[XB_TOPGEN]) == tg, bar);
            __builtin_amdgcn_fence(__ATOMIC_ACQUIRE, "agent");
            xb_add(&bar[XB_XGEN(b.x)], 1u);
            asm volatile("s_waitcnt vmcnt(0)" ::: "memory");
        } else {
            XB_SPIN(xb_ld(&bar[XB_XGEN(b.x)]) == gen, bar);
            __builtin_amdgcn_fence(__ATOMIC_ACQUIRE, "agent");
            asm volatile("s_waitcnt vmcnt(0)" ::: "memory");
        }
    }
    __syncthreads();
}

#if MEGA
__global__ void __launch_bounds__(512, 2) fwd_kernel(Params p) {
    extern __shared__ __attribute__((aligned(16))) unsigned char smem[];
    LAS unsigned char* lds = (LAS unsigned char*)smem;
    cg::grid_group grid = cg::this_grid();
    volatile LAS unsigned* xst = (volatile LAS unsigned*)(lds + LDS_BYTES - 16);
    if (threadIdx.x < 4) xst[threadIdx.x] = 0u;
    __syncthreads();
    const XcdBarrier xb = xcd_barrier_post((unsigned*)(p.ws + OFF_XBAR), xst);
    run_phase<0>(p, 0, lds); grid.sync();
#pragma unroll 1
    for (int l = 0; l < 2; ++l) {
        run_phase<1>(p, l, lds); xcd_barrier(xb);
        run_phase<6>(p, l, lds); xcd_barrier(xb);
        run_phase<2>(p, l, lds); xcd_barrier(xb);
        run_phase<3>(p, l, lds); xcd_barrier(xb);
        run_phase<4>(p, l, lds); xcd_barrier(xb);
    }
    run_phase<5>(p, 0, lds);
}
#else
template <int K>
__global__ void __launch_bounds__(512, 2) k_phase(Params p, int l) {
    extern __shared__ __attribute__((aligned(16))) unsigned char smem[];
    run_phase<K>(p, l, (LAS unsigned char*)smem);
}
#endif

template <int K> static void launch_phase(const Params& p, int l, int grid, hipStream_t stream) {
#if !MEGA
    static bool attr = false;
    if (!attr) { if (hipFuncSetAttribute((const void*)k_phase<K>, hipFuncAttributeMaxDynamicSharedMemorySize, LDS_BYTES) != hipSuccess) fprintf(stderr, "hipFuncSetAttribute failed (phase %d)\n", K); attr = true; }
    hipLaunchKernelGGL((k_phase<K>), dim3(grid), dim3(512), LDS_BYTES, stream, p, l);
#endif
}

extern "C" void kernel_launch(void* const* d_in, const int* in_sizes, int n_in, void* d_out, int out_size, void* d_ws, size_t ws_size, hipStream_t stream) {
    static int grid = 0;
    if (grid == 0) {
        if (n_in != 14 || ws_size < WS_END) { fprintf(stderr, "kernel_launch: unexpected n_in %d / ws %zu (need %zu)\n", n_in, ws_size, (size_t)WS_END); grid = -1; return; }
        int dev = 0, cus = 0;
        (void)hipGetDevice(&dev);
        (void)hipDeviceGetAttribute(&cus, hipDeviceAttributeMultiprocessorCount, dev);
#if MEGA
        int per_cu = 0;
        if (hipFuncSetAttribute((const void*)fwd_kernel, hipFuncAttributeMaxDynamicSharedMemorySize, LDS_BYTES) != hipSuccess) fprintf(stderr, "kernel_launch: hipFuncSetAttribute failed\n");
        if (hipOccupancyMaxActiveBlocksPerMultiprocessor(&per_cu, (const void*)fwd_kernel, 512, LDS_BYTES) != hipSuccess || per_cu < 1) fprintf(stderr, "kernel_launch: occupancy query says %d\n", per_cu);
        (void)hipGetLastError();
#endif
        grid = cus;
        if (grid > 256 || grid < 1) grid = 256;
    }
    if (grid < 0) return;
    Params p{};
    p.x = (const float*)d_in[0]; p.meta = (const float*)d_in[1]; p.norm_w = (const float*)d_in[2]; p.w_in = (const float*)d_in[3]; p.conv_w = (const float*)d_in[4];
    p.a_log = (const float*)d_in[5]; p.dt_bias = (const float*)d_in[6]; p.gnorm_a = (const float*)d_in[7]; p.gnorm_b = (const float*)d_in[8]; p.lbraw = (const float*)d_in[9];
    p.wba = (const float*)d_in[10]; p.wbb = (const float*)d_in[11]; p.wout = (const float*)d_in[12]; p.fnw = (const float*)d_in[13];
    p.out = (float*)d_out; p.ws = (unsigned char*)d_ws;
#if MEGA
    (void)hipMemsetAsync((unsigned char*)d_ws + OFF_XBAR, 0, 16384, stream);
    void* args[] = {&p};
    hipError_t e = hipLaunchCooperativeKernel((const void*)fwd_kernel, dim3(grid), dim3(512), args, LDS_BYTES, stream);
    if (e != hipSuccess) fprintf(stderr, "cooperative launch failed: %s (grid %d)\n", hipGetErrorString(e), grid);
#else
    launch_phase<0>(p, 0, grid, stream);
    for (int l = 0; l < 2; ++l) { launch_phase<1>(p, l, grid, stream); launch_phase<6>(p, l, grid, stream); launch_phase<2>(p, l, grid, stream); launch_phase<3>(p, l, grid, stream); launch_phase<4>(p, l, grid, stream); }
    launch_phase<5>(p, 0, grid, stream);
#endif
}
```
